# Optimizing an MI355X kernel written in HIP

```python
import jax, jax.numpy as jnp
from jax import lax
import numpy as np

D_MODEL = 1024
BATCH = 16
SEQ = 256
DEPTH = 4
DEC_BATCH = 2
DEC_SEQ = 1024
PAST_LEN = 256

GRID_W = 64
N_HEADS_A = 8
N_KV_A = 2
HD_A = 64
Q_BLOCK = 128
ROPE_THETA = 10000.0
N_HEADS_B = 4
DK_B = 64
DV_B = 128
GK_RANK = 16
GK_NORMALIZER = 16.0
GLA_CHUNK = 64
N_HEADS_C = 8
HD_C = 64
W_LORA = 64
A_LORA = 64
G_LORA = 128
GN_EPS = 64e-5
NORM_EPS = 1e-6
WIDTH_A = N_HEADS_A * HD_A
KV_A = N_KV_A * HD_A
WIDTH_BK = N_HEADS_B * DK_B
WIDTH_BV = N_HEADS_B * DV_B
WIDTH_C = N_HEADS_C * HD_C
N_BRANCH = 3
D_FF = ((8 * D_MODEL + 3 * 256 - 1) // (3 * 256)) * 256
OFF_QA = 0
OFF_KA = OFF_QA + WIDTH_A
OFF_VA = OFF_KA + KV_A
OFF_QB = OFF_VA + KV_A
OFF_KB = OFF_QB + WIDTH_BK
OFF_VB = OFF_KB + WIDTH_BK
OFF_GB = OFF_VB + WIDTH_BV
OFF_GKF = OFF_GB + WIDTH_BV
OFF_GKB = OFF_GKF + GK_RANK
OFF_C = OFF_GKB + GK_RANK
C_COLS = 3 * WIDTH_C + 2 * W_LORA + 2 * A_LORA + G_LORA
OFF_GATE = OFF_C + C_COLS
N_IN = OFF_GATE + N_BRANCH * D_MODEL
C_R = 0
C_K = C_R + WIDTH_C
C_V = C_K + WIDTH_C
C_WF = C_V + WIDTH_C
C_WB = C_WF + W_LORA
C_AF = C_WB + W_LORA
C_AB = C_AF + A_LORA
C_G = C_AB + A_LORA

kernel_name = 'hybrid_diffusion_prefix_gqa_gla_rwkv7_step'


def rms_norm(x, g, eps=NORM_EPS):
    xf = x.astype(jnp.float32)
    y = xf * lax.rsqrt(jnp.mean(xf * xf, axis=-1, keepdims=True) + eps)
    return (y * g.astype(jnp.float32)).astype(x.dtype)


def flip_t(a):
    return jnp.flip(a, axis=1)


def axial_rope(x):
    T = x.shape[1]
    rows = T // GRID_W
    t = jnp.arange(rows * GRID_W)
    row = (t // GRID_W).astype(jnp.float32)
    col = (t % GRID_W).astype(jnp.float32)
    n_pairs = HD_A // 4
    inv = ROPE_THETA ** (-jnp.arange(n_pairs, dtype=jnp.float32) / n_pairs)
    ang = jnp.concatenate([row[:, None] * inv, col[:, None] * inv], axis=-1)
    cos = jnp.cos(ang)[None, :, None, :]
    sin = jnp.sin(ang)[None, :, None, :]
    xp = x.astype(jnp.float32).reshape(x.shape[:-1] + (HD_A // 2, 2))
    x0, x1 = xp[..., 0], xp[..., 1]
    out = jnp.stack([x0 * cos - x1 * sin, x0 * sin + x1 * cos], axis=-1)
    return out.reshape(x.shape).astype(x.dtype)


def block_attention(q, k, v):
    B, Tq, H, hd = q.shape
    G = H // N_KV_A
    nb = Tq // Q_BLOCK
    qb = q.reshape(B, nb, Q_BLOCK, N_KV_A, G, hd).transpose(1, 0, 2, 3, 4, 5)
    scale = hd ** -0.5

    def one_block(qblk):
        s = jnp.einsum('bqkgd,bskd->bkgqs', qblk, k, preferred_element_type=jnp.float32) * scale
        p = jax.nn.softmax(s, axis=-1)
        return jnp.einsum('bkgqs,bskd->bqkgd', p.astype(v.dtype), v)

    o = lax.map(one_block, qb)
    return o.transpose(1, 0, 2, 3, 4, 5).reshape(B, Tq, H * hd)


def gla_chunked(q, k, v, log_a, s0):
    B, T, H, dk = q.shape
    dv = v.shape[-1]
    n = T // GLA_CHUNK

    def chunks(a):
        return a.astype(jnp.float32).reshape(B, n, GLA_CHUNK, H, a.shape[-1]).transpose(1, 0, 3, 2, 4)

    causal = jnp.tril(jnp.ones((GLA_CHUNK, GLA_CHUNK), dtype=bool))[:, :, None]

    def step(s, inp):
        qc, kc, vc, gc = inp
        b = jnp.cumsum(gc, axis=2)
        o_inter = jnp.einsum('bhcd,bhde->bhce', qc * jnp.exp(b), s)
        rel = jnp.where(causal, b[:, :, :, None, :] - b[:, :, None, :, :], -jnp.inf)
        att = jnp.sum(qc[:, :, :, None, :] * kc[:, :, None, :, :] * jnp.exp(rel), axis=-1)
        o_intra = jnp.einsum('bhij,bhje->bhie', att, vc)
        b_last = b[:, :, -1:, :]
        s_new = jnp.exp(b_last[:, :, 0, :])[..., None] * s + jnp.einsum('bhcd,bhce->bhde', kc * jnp.exp(b_last - b), vc)
        return s_new, o_inter + o_intra

    s_fin, o = lax.scan(step, s0.astype(jnp.float32), (chunks(q), chunks(k), chunks(v), chunks(log_a)))
    return o.transpose(1, 0, 3, 2, 4).reshape(B, T, H, dv), s_fin


def rwkv7_scan(r, decay, k, v, a_vec, b_vec, s0):
    def step(s, inp):
        rt, wt, kt, vt, at, bt = inp
        sa = jnp.einsum('bhij,bhj->bhi', s, at)
        s = s * wt[:, :, None, :] + sa[..., None] * bt[:, :, None, :] + vt[..., None] * kt[:, :, None, :]
        return s, jnp.einsum('bhij,bhj->bhi', s, rt)

    seq = tuple(z.astype(jnp.float32).transpose(1, 0, 2, 3) for z in (r, decay, k, v, a_vec, b_vec))
    s_fin, y = lax.scan(step, s0.astype(jnp.float32), seq)
    return y.transpose(1, 0, 2, 3), s_fin


def centred_shift(u, mu):
    prev = jnp.pad(u[:, :-1], ((0, 0), (1, 0), (0, 0)))
    nxt = jnp.pad(u[:, 1:], ((0, 0), (0, 1), (0, 0)))
    return u + mu * (0.5 * (prev + nxt) - u)


def trunk_layer(x, cond, lp, ctx):
    (w_ada, b_ada, g_mix, g_ffn, w_in, q_gain, k_gain, gk_w2, gk_b, gla_gain,
     mu_c, w0, w2, a0, a2, g2, k_k, k_a, r_k, lnx_w, lnx_b,
     w_po_a, w_po_b, w_po_c, w_out, w_ffn_in, w_ffn_out) = lp
    B, T, _ = x.shape
    latent = ctx is not None
    mod = (jax.nn.silu(cond) @ w_ada + b_ada)[:, None, :]
    sh1, sc1, gt1, sh2, sc2, gt2 = jnp.split(mod, 6, axis=-1)
    h = rms_norm(x, g_mix) * (1 + sc1) + sh1
    p = h @ w_in

    qa = rms_norm(p[..., OFF_QA:OFF_KA].reshape(B, T, N_HEADS_A, HD_A), q_gain)
    ka = rms_norm(p[..., OFF_KA:OFF_VA].reshape(B, T, N_KV_A, HD_A), k_gain)
    va = p[..., OFF_VA:OFF_QB].reshape(B, T, N_KV_A, HD_A)
    if latent:
        keys = jnp.concatenate([ctx[0].astype(x.dtype), axial_rope(ka)], axis=1)
        vals = jnp.concatenate([ctx[1].astype(x.dtype), va], axis=1)
        o_a = block_attention(axial_rope(qa), keys, vals)
    else:
        o_a = block_attention(qa, ka, va)

    qb = p[..., OFF_QB:OFF_KB].reshape(B, T, N_HEADS_B, DK_B) * (DK_B ** -0.5)
    kb = p[..., OFF_KB:OFF_VB].reshape(B, T, N_HEADS_B, DK_B)
    vb = p[..., OFF_VB:OFF_GB].reshape(B, T, N_HEADS_B, DV_B)
    gb = p[..., OFF_GB:OFF_GKF]

    def log_decay(lr, d):
        z = (lr @ gk_w2[d] + gk_b[d]).astype(jnp.float32)
        return (jax.nn.log_sigmoid(z) / GK_NORMALIZER).reshape(B, T, N_HEADS_B, DK_B)

    lg_f = log_decay(p[..., OFF_GKF:OFF_GKB], 0)
    lg_b = log_decay(p[..., OFF_GKB:OFF_C], 1)
    if latent:
        sg_f0, sg_b0 = ctx[2][:, 0], ctx[2][:, 1]
    else:
        sg_f0 = jnp.zeros((B, N_HEADS_B, DK_B, DV_B), jnp.float32)
        sg_b0 = sg_f0
    ob_f, sg_f = gla_chunked(qb, kb, vb, lg_f, sg_f0)
    ob_b, sg_b = gla_chunked(flip_t(qb), flip_t(kb), flip_t(vb), flip_t(lg_b), sg_b0)
    o_b = (ob_f + flip_t(ob_b)).astype(x.dtype)
    o_b = rms_norm(o_b, gla_gain).reshape(B, T, WIDTH_BV) * jax.nn.silu(gb)

    pc = centred_shift(p[..., OFF_C:OFF_GATE], mu_c)
    heads = lambda z: z.reshape(B, T, N_HEADS_C, HD_C)
    r = heads(pc[..., C_R:C_K]).astype(jnp.float32)
    kc = pc[..., C_K:C_V]
    vc = heads(pc[..., C_V:C_WF]).astype(jnp.float32)
    kkf = heads(kc * k_k).astype(jnp.float32)
    kk = kkf * lax.rsqrt(jnp.sum(kkf * kkf, axis=-1, keepdims=True) + 1e-12)

    def dir_terms(d, wlr, alr):
        wl = (w0[d] + jnp.tanh(wlr) @ w2[d]).astype(jnp.float32)
        decay = jnp.exp(-jnp.exp(-jax.nn.softplus(-wl) - 0.5))
        a = jax.nn.sigmoid((a0[d] + alr @ a2[d]).astype(jnp.float32))
        kd = kc.astype(jnp.float32) * (1 + (a - 1) * k_a.astype(jnp.float32))
        return heads(decay), heads(a), heads(kd)

    dec_f, a_f, kd_f = dir_terms(0, pc[..., C_WF:C_WB], pc[..., C_AF:C_AB])
    dec_b, a_b, kd_b = dir_terms(1, pc[..., C_WB:C_AF], pc[..., C_AB:C_G])
    if latent:
        sr_f0, sr_b0 = ctx[3][:, 0], ctx[3][:, 1]
    else:
        sr_f0 = jnp.zeros((B, N_HEADS_C, HD_C, HD_C), jnp.float32)
        sr_b0 = sr_f0
    y_f, sr_f = rwkv7_scan(r, dec_f, kd_f, vc, -kk, kk * a_f, sr_f0)
    y_b, sr_b = rwkv7_scan(flip_t(r), flip_t(dec_b), flip_t(kd_b), flip_t(vc),
                           flip_t(-kk), flip_t(kk * a_b), sr_b0)
    y = y_f + flip_t(y_b)
    mean = jnp.mean(y, axis=-1, keepdims=True)
    var = jnp.var(y, axis=-1, keepdims=True)
    gn = ((y - mean) * lax.rsqrt(var + GN_EPS)).reshape(B, T, WIDTH_C) * lnx_w + lnx_b
    rkf = r_k.astype(jnp.float32)
    bonus = (jnp.sum(r * kd_f * rkf, axis=-1, keepdims=True) + jnp.sum(r * kd_b * rkf, axis=-1, keepdims=True)) * vc
    g_c = jax.nn.sigmoid(pc[..., C_G:]) @ g2
    o_c = ((gn + bonus.reshape(B, T, WIDTH_C)) * g_c).astype(x.dtype)

    gates = jax.nn.sigmoid(p[..., OFF_GATE:].astype(jnp.float32)).astype(x.dtype).reshape(B, T, N_BRANCH, D_MODEL)
    merged = (gates[..., 0, :] * (o_a @ w_po_a) + gates[..., 1, :] * (o_b @ w_po_b)
              + gates[..., 2, :] * (o_c @ w_po_c))
    x = x + gt1 * (merged @ w_out)

    h2 = rms_norm(x, g_ffn) * (1 + sc2) + sh2
    gu = h2 @ w_ffn_in
    x = x + gt2 * ((jax.nn.silu(gu[..., :D_FF]) * gu[..., D_FF:]) @ w_ffn_out)

    if latent:
        return x, None
    return x, (ka, va, jnp.stack([sg_f, sg_b], axis=1), jnp.stack([sr_f, sr_b], axis=1))


def setup_inputs(seed: int = 0) -> dict:
    key = jax.random.key(seed)
    ks = iter(jax.random.split(key, 40))
    L = DEPTH
    D = D_MODEL

    def nrm(shape, scale=1.0):
        return jax.random.normal(next(ks), shape, jnp.float32) * scale

    def uni(shape, lo, hi):
        return jax.random.uniform(next(ks), shape, jnp.float32, lo, hi)

    return {
        'x_prompt': nrm((BATCH, SEQ, D)),
        'x_sample': nrm((DEC_BATCH, DEC_SEQ, D)),
        'cache_k': nrm((DEC_BATCH, L, PAST_LEN, N_KV_A, HD_A)),
        'cache_v': nrm((DEC_BATCH, L, PAST_LEN, N_KV_A, HD_A)),
        'state_gla': nrm((DEC_BATCH, L, 2, N_HEADS_B, DK_B, DV_B), 0.5),
        'state_rwkv': nrm((DEC_BATCH, L, 2, N_HEADS_C, HD_C, HD_C), 0.5),
        'c': nrm((DEC_BATCH, D)),
        'c_ctx': nrm((D,)),
        'w_ada': nrm((L, D, 6 * D), 0.5 * D ** -0.5),
        'b_ada': nrm((L, 6 * D), 0.02),
        'g_mix': 1.0 + nrm((L, D), 0.02),
        'g_ffn': 1.0 + nrm((L, D), 0.02),
        'w_in': nrm((L, D, N_IN), D ** -0.5),
        'q_gain': 1.0 + nrm((L, HD_A), 0.02),
        'k_gain': 1.0 + nrm((L, HD_A), 0.02),
        'gk_w2': nrm((L, 2, GK_RANK, WIDTH_BK), GK_RANK ** -0.5),
        'gk_b': nrm((L, 2, WIDTH_BK), 0.1),
        'gla_gain': 1.0 + nrm((L, DV_B), 0.02),
        'mu_c': uni((L, C_COLS), 0.0, 1.0),
        'w0': uni((L, 2, WIDTH_C), -5.0, -1.0),
        'w2': nrm((L, 2, W_LORA, WIDTH_C), 0.1 * W_LORA ** -0.5),
        'a0': nrm((L, 2, WIDTH_C), 0.1),
        'a2': nrm((L, 2, A_LORA, WIDTH_C), 0.1 * A_LORA ** -0.5),
        'g2': nrm((L, G_LORA, WIDTH_C), G_LORA ** -0.5),
        'k_k': 0.85 + nrm((L, WIDTH_C), 0.02),
        'k_a': 1.0 + nrm((L, WIDTH_C), 0.02),
        'r_k': nrm((L, N_HEADS_C, HD_C), 0.1),
        'lnx_w': 1.0 + nrm((L, WIDTH_C), 0.02),
        'lnx_b': nrm((L, WIDTH_C), 0.02),
        'w_po_a': nrm((L, WIDTH_A, D), WIDTH_A ** -0.5),
        'w_po_b': nrm((L, WIDTH_BV, D), WIDTH_BV ** -0.5),
        'w_po_c': nrm((L, WIDTH_C, D), WIDTH_C ** -0.5),
        'w_out': nrm((L, D, D), D ** -0.5),
        'w_ffn_in': nrm((L, D, 2 * D_FF), D ** -0.5),
        'w_ffn_out': nrm((L, D_FF, D), D_FF ** -0.5),
    }


def reference(x_prompt, x_sample, cache_k, cache_v, state_gla, state_rwkv, c, c_ctx,
              w_ada, b_ada, g_mix, g_ffn, w_in, q_gain, k_gain, gk_w2, gk_b, gla_gain,
              mu_c, w0, w2, a0, a2, g2, k_k, k_a, r_k, lnx_w, lnx_b,
              w_po_a, w_po_b, w_po_c, w_out, w_ffn_in, w_ffn_out):
    y_prompt = x_prompt
    y_sample = x_sample
    cond_ctx = c_ctx[None, :]
    ks, vs, sgs, srs = [], [], [], []
    for li in range(DEPTH):
        lp = (w_ada[li], b_ada[li], g_mix[li], g_ffn[li], w_in[li], q_gain[li], k_gain[li],
              gk_w2[li], gk_b[li], gla_gain[li], mu_c[li], w0[li], w2[li], a0[li], a2[li], g2[li],
              k_k[li], k_a[li], r_k[li], lnx_w[li], lnx_b[li], w_po_a[li], w_po_b[li], w_po_c[li],
              w_out[li], w_ffn_in[li], w_ffn_out[li])
        y_prompt, (k_l, v_l, sg_l, sr_l) = trunk_layer(y_prompt, cond_ctx, lp, None)
        ks.append(k_l)
        vs.append(v_l)
        sgs.append(sg_l)
        srs.append(sr_l)
        y_sample, _ = trunk_layer(y_sample, c, lp,
                                  (cache_k[:, li], cache_v[:, li], state_gla[:, li], state_rwkv[:, li]))
    new_cache_k = jnp.stack(ks, axis=1)
    new_cache_v = jnp.stack(vs, axis=1)
    new_state_gla = jnp.stack(sgs, axis=1)
    new_state_rwkv = jnp.stack(srs, axis=1)
    return (y_prompt, y_sample, new_cache_k, new_cache_v, new_state_gla, new_state_rwkv)
```

```cpp
#include <hip/hip_runtime.h>
#include <hip/hip_cooperative_groups.h>
#include <stdint.h>
#include <cstdio>
namespace cg = cooperative_groups;

#ifndef MEGA
#define MEGA 0
#endif

typedef unsigned short u16;
typedef __attribute__((ext_vector_type(8))) short bf16x8;
typedef __attribute__((ext_vector_type(4))) short bf16x4;
typedef __attribute__((ext_vector_type(16))) float f32x16;

constexpr int D = 1024;
constexpr int NTOK = 6144;
constexpr int NCTX = 4096;
constexpr int DEPTH = 4;
constexpr int NIN = 7328;
constexpr int LDP = 7424;
constexpr int DFF = 2816;
constexpr int OFF_KA = 512, OFF_VA = 640, OFF_QB = 768, OFF_KB = 1024, OFF_VB = 1280, OFF_GB = 1792,
              OFF_GKF = 2304, OFF_GKB = 2320, OFF_C = 2336, OFF_GATE = 4256;
constexpr int NTHREADS = 256;

enum { I_XP = 0, I_XS, I_CK, I_CV, I_SG, I_SR, I_C, I_CCTX, I_WADA, I_BADA, I_GMIX, I_GFFN, I_WIN, I_QG, I_KG,
       I_GKW2, I_GKB, I_GLAG, I_MU, I_W0, I_W2, I_A0, I_A2, I_G2, I_KK, I_KA, I_RK, I_LNW, I_LNB,
       I_WPA, I_WPB, I_WPC, I_WOUT, I_WFI, I_WFO, N_INPUTS };

constexpr size_t O_YP = 0, O_YS = 4194304, O_CK = 6291456, O_CV = 8388608, O_SG = 10485760, O_SR = 14680064;

constexpr size_t WB_IN = 0;
constexpr size_t WB_PO = WB_IN + (size_t)LDP * 1024;
constexpr size_t WB_OUT = WB_PO + (size_t)3 * 1024 * 512;
constexpr size_t WB_FI = WB_OUT + (size_t)1024 * 1024;
constexpr size_t WB_FO = WB_FI + (size_t)5632 * 1024;
constexpr size_t WB_TOTAL = WB_FO + (size_t)1024 * 2816;

struct Params {
  const float* in[N_INPUTS];
  float* out;
  u16* wb[2];
  float* mod;
  u16* h;
  u16* p;
  u16* qbuf;
  u16* kctx;
  u16* vtctx;
  u16* klat;
  u16* vtlat;
  u16* gqe;
  u16* gke;
  u16* gklT;
  u16* gvT;
  float* gdl;
  float* ob;
  float* rr;
  float* rv;
  float* rnkk;
  float* rdec;
  float* rkd;
  float* rbk;
  float* rgc;
  float* rbon;
  float* ry;
  u16* ocat;
};

__device__ __forceinline__ int ltid() { int t = threadIdx.x; asm volatile("" : "+v"(t)); return t; }
__device__ __forceinline__ int lbid() { int t = blockIdx.x; asm volatile("" : "+s"(t)); return t; }
__device__ __forceinline__ u16 f2bf(float f) {
  unsigned u = __float_as_uint(f);
  u += 0x7fffu + ((u >> 16) & 1u);
  return (u16)(u >> 16);
}
__device__ __forceinline__ float bf2f(u16 b) { return __uint_as_float(((unsigned)b) << 16); }
__device__ __forceinline__ unsigned pack2(float a, float b) { return (unsigned)f2bf(a) | ((unsigned)f2bf(b) << 16); }
__device__ __forceinline__ float sigmoidf_(float x) { return 1.f / (1.f + __expf(-x)); }
__device__ __forceinline__ float siluf_(float x) { return x / (1.f + __expf(-x)); }
__device__ __forceinline__ float softplusf_(float x) { return fmaxf(x, 0.f) + log1pf(__expf(-fabsf(x))); }

template <int CTRL>
__device__ __forceinline__ float dpp_addf(float x) {
  int xi = __float_as_int(x);
  int yi = __builtin_amdgcn_update_dpp(xi, xi, CTRL, 0xF, 0xF, false);
  return x + __int_as_float(yi);
}
template <int N>
__device__ __forceinline__ float group_sum(float x) {
  x = dpp_addf<0xB1>(x);
  x = dpp_addf<0x4E>(x);
  x = dpp_addf<0x141>(x);
  if (N >= 16) x = dpp_addf<0x140>(x);
  if (N >= 32) x += __shfl_xor(x, 16, 64);
  if (N >= 64) x += __shfl_xor(x, 32, 64);
  return x;
}

__device__ __forceinline__ void unpack8(uint4 r, float* v) {
  v[0] = __uint_as_float(r.x << 16); v[1] = __uint_as_float(r.x & 0xffff0000u);
  v[2] = __uint_as_float(r.y << 16); v[3] = __uint_as_float(r.y & 0xffff0000u);
  v[4] = __uint_as_float(r.z << 16); v[5] = __uint_as_float(r.z & 0xffff0000u);
  v[6] = __uint_as_float(r.w << 16); v[7] = __uint_as_float(r.w & 0xffff0000u);
}
__device__ __forceinline__ uint4 pack8(const float* v) {
  uint4 r; r.x = pack2(v[0], v[1]); r.y = pack2(v[2], v[3]); r.z = pack2(v[4], v[5]); r.w = pack2(v[6], v[7]);
  return r;
}
__device__ __forceinline__ f32x16 zero16() {
  f32x16 z;
#pragma unroll
  for (int i = 0; i < 16; ++i) z[i] = 0.f;
  return z;
}
__device__ __forceinline__ f32x16 mfma(bf16x8 a, bf16x8 b, f32x16 c) {
  return __builtin_amdgcn_mfma_f32_32x32x16_bf16(a, b, c, 0, 0, 0);
}
__device__ __forceinline__ int accrow(int r, int h) { return (r & 3) + 8 * (r >> 2) + 4 * h; }

__device__ __forceinline__ bf16x8 ld8(const u16* p) { return *reinterpret_cast<const bf16x8*>(p); }
__device__ __forceinline__ bf16x8 ld4x2(const u16* p0, const u16* p1) {
  bf16x4 a = *reinterpret_cast<const bf16x4*>(p0);
  bf16x4 b = *reinterpret_cast<const bf16x4*>(p1);
  bf16x8 r;
  r[0] = a[0]; r[1] = a[1]; r[2] = a[2]; r[3] = a[3]; r[4] = b[0]; r[5] = b[1]; r[6] = b[2]; r[7] = b[3];
  return r;
}
__device__ __forceinline__ bf16x8 acc2frag(const f32x16& x, int s) {
  bf16x8 r;
#pragma unroll
  for (int j = 0; j < 8; ++j) r[j] = (short)f2bf(x[8 * s + j]);
  return r;
}

__device__ __forceinline__ void seq_info(int s, int& base, int& T) {
  if (s < 16) { base = s * 256; T = 256; } else { base = NCTX + (s - 16) * 1024; T = 1024; }
}
__device__ __forceinline__ int cond_of(int m) { return m < NCTX ? 0 : 1 + ((m - NCTX) >> 10); }

__device__ __forceinline__ void convert_tile(const float* __restrict__ src, int Nsrc, u16* __restrict__ dst, int K, int kt, int nt,
                             int kind, char* smem) {
  float* tile = (float*)smem;
  int tid = ltid();
  __syncthreads();
#pragma unroll
  for (int pss = 0; pss < 4; ++pss) {
    int kr = pss * 16 + (tid >> 4);
    int nl = (tid & 15) * 4;
    int scol;
    if (kind == 5) scol = (nl < 32) ? (32 * nt + nl) : (DFF + 32 * nt + nl - 32);
    else scol = nt * 64 + nl;
    float4 v = make_float4(0.f, 0.f, 0.f, 0.f);
    if (scol < Nsrc) v = *reinterpret_cast<const float4*>(src + (size_t)(kt * 64 + kr) * Nsrc + scol);
    tile[kr * 65 + nl + 0] = v.x; tile[kr * 65 + nl + 1] = v.y; tile[kr * 65 + nl + 2] = v.z; tile[kr * 65 + nl + 3] = v.w;
  }
  __syncthreads();
  int n = tid >> 2, ks = (tid & 3) * 16;
  float v[16];
#pragma unroll
  for (int i = 0; i < 16; ++i) v[i] = tile[(ks + i) * 65 + n];
  u16* dp = dst + (size_t)(nt * 64 + n) * K + kt * 64 + ks;
  *reinterpret_cast<uint4*>(dp) = pack8(v);
  *reinterpret_cast<uint4*>(dp + 8) = pack8(v + 8);
}
constexpr int CV_IN = 16 * 116, CV_PO = 8 * 16, CV_OUT = 16 * 16, CV_FI = 16 * 88, CV_FO = 44 * 16;
constexpr int CV_TOTAL = CV_IN + 3 * CV_PO + CV_OUT + CV_FI + CV_FO;
__device__ __forceinline__ void convert_item(const Params& P, int layer, int it, char* smem) {
  u16* wb = P.wb[layer & 1];
  if (it < CV_IN) { convert_tile(P.in[I_WIN] + (size_t)layer * 1024 * NIN, NIN, wb + WB_IN, 1024, it % 16, it / 16, 0, smem); return; }
  it -= CV_IN;
  if (it < 3 * CV_PO) {
    int w = it / CV_PO, r = it % CV_PO;
    convert_tile(P.in[I_WPA + w] + (size_t)layer * 512 * 1024, 1024, wb + WB_PO + (size_t)w * 1024 * 512, 512, r % 8, r / 8, 1 + w, smem);
    return;
  }
  it -= 3 * CV_PO;
  if (it < CV_OUT) { convert_tile(P.in[I_WOUT] + (size_t)layer * 1024 * 1024, 1024, wb + WB_OUT, 1024, it % 16, it / 16, 4, smem); return; }
  it -= CV_OUT;
  if (it < CV_FI) { convert_tile(P.in[I_WFI] + (size_t)layer * 1024 * 5632, 5632, wb + WB_FI, 1024, it % 16, it / 16, 5, smem); return; }
  it -= CV_FI;
  convert_tile(P.in[I_WFO] + (size_t)layer * DFF * 1024, 1024, wb + WB_FO, DFF, it % 44, it / 44, 6, smem);
}

__device__ __forceinline__ void adaln_item(const Params& P, int it, char* smem) {
  int layer = it / 96, nb = it % 96;
  float* sc = (float*)smem;
  float* red = sc + 3072;
  int tid = ltid();
  __syncthreads();
  for (int e = tid; e < 3072; e += NTHREADS) {
    int c = e >> 10, k = e & 1023;
    float v = (c == 0) ? P.in[I_CCTX][k] : P.in[I_C][(c - 1) * 1024 + k];
    sc[e] = siluf_(v);
  }
  __syncthreads();
  int cg4 = (tid & 15) * 4, ks = tid >> 4;
  float acc[3][4];
#pragma unroll
  for (int c = 0; c < 3; ++c)
#pragma unroll
    for (int j = 0; j < 4; ++j) acc[c][j] = 0.f;
  const float* w = P.in[I_WADA] + (size_t)layer * 1024 * 6144 + nb * 64 + cg4;
#pragma unroll 4
  for (int i = 0; i < 64; ++i) {
    int k = i * 16 + ks;
    float4 wv = *reinterpret_cast<const float4*>(w + (size_t)k * 6144);
#pragma unroll
    for (int c = 0; c < 3; ++c) {
      float s = sc[c * 1024 + k];
      acc[c][0] += s * wv.x; acc[c][1] += s * wv.y; acc[c][2] += s * wv.z; acc[c][3] += s * wv.w;
    }
  }
#pragma unroll
  for (int c = 0; c < 3; ++c)
#pragma unroll
    for (int j = 0; j < 4; ++j) red[(ks * 3 + c) * 64 + cg4 + j] = acc[c][j];
  __syncthreads();
  if (tid < 192) {
    int c = tid >> 6, col = tid & 63;
    float s = P.in[I_BADA][layer * 6144 + nb * 64 + col];
#pragma unroll
    for (int k2 = 0; k2 < 16; ++k2) s += red[(k2 * 3 + c) * 64 + col];
    P.mod[((size_t)layer * 3 + c) * 6144 + nb * 64 + col] = s;
  }
}

__device__ __forceinline__ void cache_item(const Params& P, int it) {
  int e = it * NTHREADS + ltid();
  int d = e & 63, kvh = (e >> 6) & 1, key = (e >> 7) & 255, l = (e >> 15) & 3, b = e >> 17;
  float kv = P.in[I_CK][e], vv = P.in[I_CV][e];
  size_t hb = ((size_t)(l * 2 + b) * 2 + kvh);
  P.klat[(hb * 1280 + key) * 64 + d] = f2bf(kv);
  P.vtlat[(hb * 64 + d) * 1280 + key] = f2bf(vv);
}

__device__ __forceinline__ void norm_item(const Params& P, int layer, int which, int it) {
  int lane = ltid() & 63, wave = ltid() >> 6;
  int m = it * 4 + wave;
  const float* xrow;
  if (which == 0 && layer == 0) xrow = (m < NCTX) ? P.in[I_XP] + (size_t)m * D : P.in[I_XS] + (size_t)(m - NCTX) * D;
  else xrow = P.out + (size_t)m * D;
  const float* g = P.in[which ? I_GFFN : I_GMIX] + layer * D;
  const float* md = P.mod + ((size_t)layer * 3 + cond_of(m)) * 6144 + (which ? 3 * D : 0);
  float4 xv[4];
  float ss = 0.f;
#pragma unroll
  for (int i = 0; i < 4; ++i) {
    xv[i] = *reinterpret_cast<const float4*>(xrow + i * 256 + lane * 4);
    ss += xv[i].x * xv[i].x + xv[i].y * xv[i].y + xv[i].z * xv[i].z + xv[i].w * xv[i].w;
  }
  ss = group_sum<64>(ss);
  float rs = rsqrtf(ss * (1.f / 1024.f) + 1e-6f);
#pragma unroll
  for (int i = 0; i < 4; ++i) {
    int c = i * 256 + lane * 4;
    float4 gv = *reinterpret_cast<const float4*>(g + c);
    float4 sh = *reinterpret_cast<const float4*>(md + c);
    float4 scv = *reinterpret_cast<const float4*>(md + D + c);
    float a0 = xv[i].x * rs * gv.x * (1.f + scv.x) + sh.x;
    float a1 = xv[i].y * rs * gv.y * (1.f + scv.y) + sh.y;
    float a2 = xv[i].z * rs * gv.z * (1.f + scv.z) + sh.z;
    float a3 = xv[i].w * rs * gv.w * (1.f + scv.w) + sh.w;
    uint2 o; o.x = pack2(a0, a1); o.y = pack2(a2, a3);
    *reinterpret_cast<uint2*>(P.h + (size_t)m * D + c) = o;
  }
}

template <int BN>
__device__ __forceinline__ void gemm_core(const u16* __restrict__ A, int lda, const u16* __restrict__ B, int ldb, int K,
                                          int m0, int n0, char* smem, f32x16 (&acc)[2][BN / 64]) {
  constexpr int NB = BN / 32;
  constexpr int NI = BN / 64;
  u16* sA = (u16*)smem;
  u16* sB = sA + 2 * 128 * 64;
  const int tid = ltid(), lane = tid & 63, wave = tid >> 6;
  const int wm = wave >> 1, wn = wave & 1;
  const int lr = tid >> 3, lc = tid & 7;
  const u16* Ap = A + (size_t)(m0 + lr) * lda + lc * 8;
  const u16* Bp = B + (size_t)(n0 + lr) * ldb + lc * 8;
  uint4 ra[4], rb[NB];
#pragma unroll
  for (int i = 0; i < 4; ++i) ra[i] = *reinterpret_cast<const uint4*>(Ap + (size_t)i * 32 * lda);
#pragma unroll
  for (int i = 0; i < NB; ++i) rb[i] = *reinterpret_cast<const uint4*>(Bp + (size_t)i * 32 * ldb);
  const int nk = K >> 6;
  const int so = lr * 64 + ((lc ^ (lr & 7)) << 3);
#pragma unroll
  for (int i = 0; i < 4; ++i) *reinterpret_cast<uint4*>(sA + so + i * 32 * 64) = ra[i];
#pragma unroll
  for (int i = 0; i < NB; ++i) *reinterpret_cast<uint4*>(sB + so + i * 32 * 64) = rb[i];
  __syncthreads();
  const int r31 = lane & 31, hh = lane >> 5;
  for (int kt = 0; kt < nk; ++kt) {
    const int cur = kt & 1;
    if (kt + 1 < nk) {
#pragma unroll
      for (int i = 0; i < 4; ++i) ra[i] = *reinterpret_cast<const uint4*>(Ap + (size_t)i * 32 * lda + (kt + 1) * 64);
#pragma unroll
      for (int i = 0; i < NB; ++i) rb[i] = *reinterpret_cast<const uint4*>(Bp + (size_t)i * 32 * ldb + (kt + 1) * 64);
    }
    const u16* cA = sA + cur * 128 * 64;
    const u16* cB = sB + cur * BN * 64;
#pragma unroll
    for (int ks = 0; ks < 4; ++ks) {
      bf16x8 af[2], bfr[NI];
#pragma unroll
      for (int mi = 0; mi < 2; ++mi) {
        int row = wm * 64 + mi * 32 + r31;
        af[mi] = ld8(cA + row * 64 + (((ks * 2 + hh) ^ (row & 7)) << 3));
      }
#pragma unroll
      for (int ni = 0; ni < NI; ++ni) {
        int row = wn * (BN / 2) + ni * 32 + r31;
        bfr[ni] = ld8(cB + row * 64 + (((ks * 2 + hh) ^ (row & 7)) << 3));
      }
#pragma unroll
      for (int mi = 0; mi < 2; ++mi)
#pragma unroll
        for (int ni = 0; ni < NI; ++ni) acc[mi][ni] = mfma(af[mi], bfr[ni], acc[mi][ni]);
    }
    if (kt + 1 < nk) {
      u16* nA = sA + (cur ^ 1) * 128 * 64;
      u16* nB = sB + (cur ^ 1) * BN * 64;
#pragma unroll
      for (int i = 0; i < 4; ++i) *reinterpret_cast<uint4*>(nA + so + i * 32 * 64) = ra[i];
#pragma unroll
      for (int i = 0; i < NB; ++i) *reinterpret_cast<uint4*>(nB + so + i * 32 * 64) = rb[i];
    }
    __syncthreads();
  }
}

__device__ __forceinline__ bool tile_coords(int iter, int mt, int nt, int& tm, int& tn) {
  int G = gridDim.x, b = lbid();
  int t;
  if ((G & 7) == 0) {
    int nloc = G >> 3;
    t = ((iter * 8 + (b & 7)) * nloc) + (b >> 3);
  } else {
    t = iter * G + b;
  }
  int total = mt * nt;
  if (t >= total) return false;
  int full = nt >> 3;
  int fullTiles = full * mt * 8;
  if (t < fullTiles) {
    int band = t / (mt * 8), rem = t % (mt * 8);
    int g = rem >> 6, i = rem & 63;
    tm = g * 8 + (i & 7);
    tn = band * 8 + (i >> 3);
  } else {
    int rem = t - fullTiles;
    tm = rem % mt;
    tn = full * 8 + rem / mt;
  }
  return true;
}
__device__ __forceinline__ int tile_iters(int mt, int nt) {
  int G = gridDim.x;
  int total = mt * nt;
  if ((G & 7) == 0) {
    int nloc = G >> 3;
    int chunks = (total + nloc - 1) / nloc;
    return (chunks + 7) / 8;
  }
  return (total + G - 1) / G;
}

__device__ __forceinline__ void gemm_in_phase(const Params& P, int layer, char* smem) {
  const u16* W = P.wb[layer & 1] + WB_IN;
  const int mt = NTOK / 128, nt = LDP / 128;
  const int lane = ltid() & 63, wave = ltid() >> 6, wm = wave >> 1, wn = wave & 1;
  int iters = tile_iters(mt, nt);
  for (int it = 0; it < iters; ++it) {
    int tm, tn;
    if (!tile_coords(it, mt, nt, tm, tn)) continue;
    f32x16 acc[2][2];
#pragma unroll
    for (int a = 0; a < 2; ++a)
#pragma unroll
      for (int b = 0; b < 2; ++b) acc[a][b] = zero16();
    gemm_core<128>(P.h, D, W, D, D, tm * 128, tn * 128, smem, acc);
#pragma unroll
    for (int mi = 0; mi < 2; ++mi)
#pragma unroll
      for (int ni = 0; ni < 2; ++ni)
#pragma unroll
        for (int r = 0; r < 16; ++r) {
          int row = tm * 128 + wm * 64 + mi * 32 + accrow(r, lane >> 5);
          int col = tn * 128 + wn * 64 + ni * 32 + (lane & 31);
          P.p[(size_t)row * LDP + col] = f2bf(acc[mi][ni][r]);
        }
  }
}

__device__ __forceinline__ void gemm_po_phase(const Params& P, int layer, char* smem) {
  const u16* W = P.wb[layer & 1] + WB_PO;
  const int mt = NTOK / 128, nt = D / 64;
  const int lane = ltid() & 63, wave = ltid() >> 6, wm = wave >> 1, wn = wave & 1;
  int iters = tile_iters(mt, nt);
  for (int it = 0; it < iters; ++it) {
    int tm, tn;
    if (!tile_coords(it, mt, nt, tm, tn)) continue;
    f32x16 tot[2];
    tot[0] = zero16(); tot[1] = zero16();
    for (int br = 0; br < 3; ++br) {
      f32x16 acc[2][1];
      acc[0][0] = zero16(); acc[1][0] = zero16();
      gemm_core<64>(P.ocat + br * 512, 1536, W + (size_t)br * 1024 * 512, 512, 512, tm * 128, tn * 64, smem, acc);
#pragma unroll
      for (int mi = 0; mi < 2; ++mi)
#pragma unroll
        for (int r = 0; r < 16; ++r) {
          int row = tm * 128 + wm * 64 + mi * 32 + accrow(r, lane >> 5);
          int col = tn * 64 + wn * 32 + (lane & 31);
          float g = sigmoidf_(bf2f(P.p[(size_t)row * LDP + OFF_GATE + br * D + col]));
          tot[mi][r] += g * acc[mi][0][r];
        }
    }
#pragma unroll
    for (int mi = 0; mi < 2; ++mi)
#pragma unroll
      for (int r = 0; r < 16; ++r) {
        int row = tm * 128 + wm * 64 + mi * 32 + accrow(r, lane >> 5);
        int col = tn * 64 + wn * 32 + (lane & 31);
        P.h[(size_t)row * D + col] = f2bf(tot[mi][r]);
      }
  }
}

__device__ __forceinline__ void gemm_res_phase(const Params& P, int layer, int which, char* smem) {
  const u16* A; const u16* W; int K, lda;
  if (which == 0) { A = P.h; lda = D; W = P.wb[layer & 1] + WB_OUT; K = D; }
  else { A = P.p; lda = DFF; W = P.wb[layer & 1] + WB_FO; K = DFF; }
  const int mt = NTOK / 128, nt = D / 64;
  const int lane = ltid() & 63, wave = ltid() >> 6, wm = wave >> 1, wn = wave & 1;
  int iters = tile_iters(mt, nt);
  for (int it = 0; it < iters; ++it) {
    int tm, tn;
    if (!tile_coords(it, mt, nt, tm, tn)) continue;
    f32x16 acc[2][1];
    acc[0][0] = zero16(); acc[1][0] = zero16();
    gemm_core<64>(A, lda, W, K, K, tm * 128, tn * 64, smem, acc);
#pragma unroll
    for (int mi = 0; mi < 2; ++mi)
#pragma unroll
      for (int r = 0; r < 16; ++r) {
        int row = tm * 128 + wm * 64 + mi * 32 + accrow(r, lane >> 5);
        int col = tn * 64 + wn * 32 + (lane & 31);
        const float* xin;
        if (which == 0 && layer == 0) xin = (row < NCTX) ? P.in[I_XP] + (size_t)row * D : P.in[I_XS] + (size_t)(row - NCTX) * D;
        else xin = P.out + (size_t)row * D;
        float gt = P.mod[((size_t)layer * 3 + cond_of(row)) * 6144 + (which ? 5 * D : 2 * D) + col];
        P.out[(size_t)row * D + col] = xin[col] + gt * acc[mi][0][r];
      }
  }
}

__device__ __forceinline__ void gemm_ffi_phase(const Params& P, int layer, char* smem) {
  const u16* W = P.wb[layer & 1] + WB_FI;
  const int mt = NTOK / 128, nt = 5632 / 128;
  const int lane = ltid() & 63, wave = ltid() >> 6, wm = wave >> 1, wn = wave & 1;
  u16* act = P.p;
  int iters = tile_iters(mt, nt);
  for (int it = 0; it < iters; ++it) {
    int tm, tn;
    if (!tile_coords(it, mt, nt, tm, tn)) continue;
    f32x16 acc[2][2];
#pragma unroll
    for (int a = 0; a < 2; ++a)
#pragma unroll
      for (int b = 0; b < 2; ++b) acc[a][b] = zero16();
    gemm_core<128>(P.h, D, W, D, D, tm * 128, tn * 128, smem, acc);
    int j = tn * 2 + wn;
#pragma unroll
    for (int mi = 0; mi < 2; ++mi)
#pragma unroll
      for (int r = 0; r < 16; ++r) {
        int row = tm * 128 + wm * 64 + mi * 32 + accrow(r, lane >> 5);
        int col = j * 32 + (lane & 31);
        act[(size_t)row * DFF + col] = f2bf(siluf_(acc[mi][0][r]) * acc[mi][1][r]);
      }
  }
}

__device__ __forceinline__ void rope8(float* v, int d0, int t) {
  float row = (float)(t >> 6), col = (float)(t & 63);
#pragma unroll
  for (int i = 0; i < 4; ++i) {
    int pi = (d0 >> 1) + i;
    float pos = (pi < 16) ? row : col;
    float inv = exp2f(-(float)(pi & 15) * (13.287712379549449f / 16.f));
    float ang = pos * inv;
    float n = rintf(ang * 0.15915494309189535f);
    float rr = fmaf(-n, 6.2831855f, ang);
    rr = fmaf(-n, -1.7484555e-7f, rr);
    float sn = __sinf(rr), cs = __cosf(rr);
    float x0 = v[2 * i], x1 = v[2 * i + 1];
    v[2 * i] = x0 * cs - x1 * sn;
    v[2 * i + 1] = x0 * sn + x1 * cs;
  }
}

__device__ __forceinline__ void attn_prep_item(const Params& P, int layer, int it) {
  int lane = ltid() & 63, wave = ltid() >> 6;
  int m = it * 4 + wave;
  const u16* prow = P.p + (size_t)m * LDP;
  bool lat = m >= NCTX;
  int b, t;
  if (!lat) { b = m >> 8; t = m & 255; } else { b = (m - NCTX) >> 10; t = (m - NCTX) & 1023; }
  {
    float v[8];
    unpack8(*reinterpret_cast<const uint4*>(prow + lane * 8), v);
    float ss = 0.f;
#pragma unroll
    for (int i = 0; i < 8; ++i) ss += v[i] * v[i];
    ss = group_sum<8>(ss);
    float rs = rsqrtf(ss * (1.f / 64.f) + 1e-6f);
    int d0 = (lane & 7) * 8;
#pragma unroll
    for (int i = 0; i < 8; ++i) v[i] = v[i] * rs * P.in[I_QG][layer * 64 + d0 + i];
    if (lat) rope8(v, d0, t);
    *reinterpret_cast<uint4*>(P.qbuf + (size_t)m * 512 + lane * 8) = pack8(v);
  }
  {
    int l2 = lane & 31;
    float v[8];
    unpack8(*reinterpret_cast<const uint4*>(prow + OFF_KA + l2 * 8), v);
    float ss = 0.f;
#pragma unroll
    for (int i = 0; i < 8; ++i) ss += v[i] * v[i];
    ss = group_sum<8>(ss);
    int d0 = (l2 & 7) * 8;
    int kvh = (l2 >> 3) & 1;
    if (l2 < 16) {
      float rs = rsqrtf(ss * (1.f / 64.f) + 1e-6f);
#pragma unroll
      for (int i = 0; i < 8; ++i) v[i] = v[i] * rs * P.in[I_KG][layer * 64 + d0 + i];
      if (!lat) {
        if (lane < 32) {
          float* ok = P.out + O_CK + (((size_t)(b * 4 + layer) * 256 + t) * 2 + kvh) * 64 + d0;
          *reinterpret_cast<float4*>(ok) = make_float4(v[0], v[1], v[2], v[3]);
          *reinterpret_cast<float4*>(ok + 4) = make_float4(v[4], v[5], v[6], v[7]);
          *reinterpret_cast<uint4*>(P.kctx + (((size_t)(b * 2 + kvh)) * 256 + t) * 64 + d0) = pack8(v);
        }
      } else {
        rope8(v, d0, t);
        if (lane < 32)
          *reinterpret_cast<uint4*>(P.klat + ((((size_t)(layer * 2 + b)) * 2 + kvh) * 1280 + 256 + t) * 64 + d0) = pack8(v);
      }
    } else {
      if (lane < 32) {
        if (!lat) {
          float* ov = P.out + O_CV + (((size_t)(b * 4 + layer) * 256 + t) * 2 + kvh) * 64 + d0;
          *reinterpret_cast<float4*>(ov) = make_float4(v[0], v[1], v[2], v[3]);
          *reinterpret_cast<float4*>(ov + 4) = make_float4(v[4], v[5], v[6], v[7]);
          u16* vt = P.vtctx + ((size_t)(b * 2 + kvh) * 64 + d0) * 256 + t;
#pragma unroll
          for (int i = 0; i < 8; ++i) vt[i * 256] = f2bf(v[i]);
        } else {
          u16* vt = P.vtlat + ((((size_t)(layer * 2 + b)) * 2 + kvh) * 64 + d0) * 1280 + 256 + t;
#pragma unroll
          for (int i = 0; i < 8; ++i) vt[i * 1280] = f2bf(v[i]);
        }
      }
    }
  }
}

__device__ __forceinline__ void gla_prep_item(const Params& P, int layer, int it, char* smem) {
  int chunk = it >> 2, h = it & 3;
  int m0 = chunk * 64;
  int tid = ltid();
  float* bc = (float*)smem;
  u16* sq = (u16*)(smem + 32768);
  u16* sk = sq + 4096;
  u16* slr = sk + 4096;
  __syncthreads();
  {
    int row = tid >> 2, seg = (tid & 3) * 16;
    const u16* pr = P.p + (size_t)(m0 + row) * LDP;
    *reinterpret_cast<uint4*>(sq + row * 64 + seg) = *reinterpret_cast<const uint4*>(pr + OFF_QB + h * 64 + seg);
    *reinterpret_cast<uint4*>(sq + row * 64 + seg + 8) = *reinterpret_cast<const uint4*>(pr + OFF_QB + h * 64 + seg + 8);
    *reinterpret_cast<uint4*>(sk + row * 64 + seg) = *reinterpret_cast<const uint4*>(pr + OFF_KB + h * 64 + seg);
    *reinterpret_cast<uint4*>(sk + row * 64 + seg + 8) = *reinterpret_cast<const uint4*>(pr + OFF_KB + h * 64 + seg + 8);
    int part = tid & 3;
    *reinterpret_cast<uint4*>(slr + ((part >> 1) * 64 + row) * 16 + (part & 1) * 8) =
        *reinterpret_cast<const uint4*>(pr + OFF_GKF + part * 8);
  }
  __syncthreads();
  {
    int dk = tid & 63, tg = tid >> 6;
#pragma unroll
    for (int dir = 0; dir < 2; ++dir) {
      float w[16];
#pragma unroll
      for (int r = 0; r < 16; ++r) w[r] = P.in[I_GKW2][((size_t)(layer * 2 + dir) * 16 + r) * 256 + h * 64 + dk];
      float bias = P.in[I_GKB][(layer * 2 + dir) * 256 + h * 64 + dk];
      for (int tt = 0; tt < 16; ++tt) {
        int t = tg * 16 + tt;
        float z = bias;
#pragma unroll
        for (int r = 0; r < 16; ++r) z += bf2f(slr[(dir * 64 + t) * 16 + r]) * w[r];
        float ls = fminf(z, 0.f) - log1pf(__expf(-fabsf(z)));
        bc[(dir * 64 + t) * 64 + dk] = ls * (1.f / 16.f);
      }
    }
  }
  __syncthreads();
  if (tid < 128) {
    int dk = tid & 63, dir = tid >> 6;
    float run = 0.f;
    if (dir == 0) { for (int t = 0; t < 64; ++t) { run += bc[t * 64 + dk]; bc[t * 64 + dk] = run; } }
    else { for (int t = 63; t >= 0; --t) { run += bc[(64 + t) * 64 + dk]; bc[(64 + t) * 64 + dk] = run; } }
  }
  __syncthreads();
  {
    int t = tid >> 2, seg = (tid & 3) * 16;
#pragma unroll
    for (int dir = 0; dir < 2; ++dir) {
      float qv[16], kv[16];
#pragma unroll
      for (int i = 0; i < 16; ++i) {
        float bb = bc[(dir * 64 + t) * 64 + seg + i];
        qv[i] = bf2f(sq[t * 64 + seg + i]) * 0.125f * __expf(bb);
        kv[i] = bf2f(sk[t * 64 + seg + i]) * __expf(-bb);
      }
      size_t o = ((size_t)dir * NTOK + m0 + t) * 256 + h * 64 + seg;
      *reinterpret_cast<uint4*>(P.gqe + o) = pack8(qv);
      *reinterpret_cast<uint4*>(P.gqe + o + 8) = pack8(qv + 8);
      *reinterpret_cast<uint4*>(P.gke + o) = pack8(kv);
      *reinterpret_cast<uint4*>(P.gke + o + 8) = pack8(kv + 8);
    }
  }
  {
    int dk = tid >> 2, iseg = (tid & 3) * 16;
#pragma unroll
    for (int dir = 0; dir < 2; ++dir) {
      float blast = bc[(dir * 64 + (dir ? 0 : 63)) * 64 + dk];
      float kv[16];
#pragma unroll
      for (int ii = 0; ii < 16; ++ii) {
        int i = iseg + ii;
        int t = dir ? 63 - i : i;
        kv[ii] = bf2f(sk[t * 64 + dk]) * __expf(blast - bc[(dir * 64 + t) * 64 + dk]);
      }
      size_t o = ((((size_t)dir * 96 + chunk) * 4 + h) * 64 + dk) * 64 + iseg;
      *reinterpret_cast<uint4*>(P.gklT + o) = pack8(kv);
      *reinterpret_cast<uint4*>(P.gklT + o + 8) = pack8(kv + 8);
      if ((tid & 3) == 0) P.gdl[((size_t)dir * 96 + chunk) * 256 + h * 64 + dk] = __expf(blast);
    }
  }
  {
    int dv = tid >> 1, iseg = (tid & 1) * 32;
#pragma unroll
    for (int dir = 0; dir < 2; ++dir) {
      size_t o = ((((size_t)dir * 96 + chunk) * 4 + h) * 128 + dv) * 64 + iseg;
#pragma unroll
      for (int g = 0; g < 4; ++g) {
        unsigned w[4];
#pragma unroll
        for (int q = 0; q < 4; ++q) {
          int i0 = iseg + g * 8 + q * 2;
          int t0 = dir ? 63 - i0 : i0, t1 = dir ? 63 - (i0 + 1) : i0 + 1;
          unsigned a = P.p[(size_t)(m0 + t0) * LDP + OFF_VB + h * 128 + dv];
          unsigned b2 = P.p[(size_t)(m0 + t1) * LDP + OFF_VB + h * 128 + dv];
          w[q] = a | (b2 << 16);
        }
        *reinterpret_cast<uint4*>(P.gvT + o + g * 8) = make_uint4(w[0], w[1], w[2], w[3]);
      }
    }
  }
}

constexpr int RT = 8;
__device__ __forceinline__ void rwkv_prep_item(const Params& P, int layer, int it, char* smem) {
  int m0 = it * RT;
  int sbase, T;
  { int s = m0 < NCTX ? (m0 >> 8) : 16 + ((m0 - NCTX) >> 10); seq_info(s, sbase, T); }
  int tid = ltid();
  float* lin = (float*)smem;
  const float* mu = P.in[I_MU] + layer * 1920;
  __syncthreads();
  for (int e = tid; e < 384 * RT; e += NTHREADS) {
    int col = e % 384, tk = e / 384;
    int m = m0 + tk, t = m - sbase;
    int gcol = OFF_C + 1536 + col;
    float u = bf2f(P.p[(size_t)m * LDP + gcol]);
    float pv = (t > 0) ? bf2f(P.p[(size_t)(m - 1) * LDP + gcol]) : 0.f;
    float nx = (t < T - 1) ? bf2f(P.p[(size_t)(m + 1) * LDP + gcol]) : 0.f;
    float pc = u + mu[1536 + col] * (0.5f * (pv + nx) - u);
    float val = (col < 128) ? tanhf(pc) : ((col < 256) ? pc : sigmoidf_(pc));
    lin[col * RT + tk] = val;
  }
  __syncthreads();
  int ch = tid * 2;
  float2 awf[RT], awb[RT], aaf[RT], aab[RT], ag[RT];
#pragma unroll
  for (int i = 0; i < RT; ++i) { awf[i] = awb[i] = aaf[i] = aab[i] = ag[i] = make_float2(0.f, 0.f); }
  const float* w2f = P.in[I_W2] + (size_t)(layer * 2 + 0) * 64 * 512 + ch;
  const float* w2b = P.in[I_W2] + (size_t)(layer * 2 + 1) * 64 * 512 + ch;
  const float* a2f = P.in[I_A2] + (size_t)(layer * 2 + 0) * 64 * 512 + ch;
  const float* a2b = P.in[I_A2] + (size_t)(layer * 2 + 1) * 64 * 512 + ch;
  const float* g2 = P.in[I_G2] + (size_t)layer * 128 * 512 + ch;
#pragma unroll 2
  for (int k = 0; k < 64; ++k) {
    float2 w1 = *reinterpret_cast<const float2*>(w2f + k * 512);
    float2 w2v = *reinterpret_cast<const float2*>(w2b + k * 512);
    float2 w3 = *reinterpret_cast<const float2*>(a2f + k * 512);
    float2 w4 = *reinterpret_cast<const float2*>(a2b + k * 512);
    const float* l1 = lin + k * RT;
    const float* l2 = lin + (64 + k) * RT;
    const float* l3 = lin + (128 + k) * RT;
    const float* l4 = lin + (192 + k) * RT;
#pragma unroll
    for (int i = 0; i < RT; ++i) {
      float s1 = l1[i], s2 = l2[i], s3 = l3[i], s4 = l4[i];
      awf[i].x += s1 * w1.x; awf[i].y += s1 * w1.y;
      awb[i].x += s2 * w2v.x; awb[i].y += s2 * w2v.y;
      aaf[i].x += s3 * w3.x; aaf[i].y += s3 * w3.y;
      aab[i].x += s4 * w4.x; aab[i].y += s4 * w4.y;
    }
  }
#pragma unroll 2
  for (int k = 0; k < 128; ++k) {
    float2 w1 = *reinterpret_cast<const float2*>(g2 + k * 512);
    const float* l1 = lin + (256 + k) * RT;
#pragma unroll
    for (int i = 0; i < RT; ++i) { float s1 = l1[i]; ag[i].x += s1 * w1.x; ag[i].y += s1 * w1.y; }
  }
  float w0f[2], w0b[2], a0f[2], a0b[2], kkc[2], kac[2], rkc[2], mur[2], muk[2], muv[2];
#pragma unroll
  for (int j = 0; j < 2; ++j) {
    w0f[j] = P.in[I_W0][(layer * 2 + 0) * 512 + ch + j];
    w0b[j] = P.in[I_W0][(layer * 2 + 1) * 512 + ch + j];
    a0f[j] = P.in[I_A0][(layer * 2 + 0) * 512 + ch + j];
    a0b[j] = P.in[I_A0][(layer * 2 + 1) * 512 + ch + j];
    kkc[j] = P.in[I_KK][layer * 512 + ch + j];
    kac[j] = P.in[I_KA][layer * 512 + ch + j];
    rkc[j] = P.in[I_RK][layer * 512 + ch + j];
    mur[j] = mu[ch + j]; muk[j] = mu[512 + ch + j]; muv[j] = mu[1024 + ch + j];
  }
#pragma unroll
  for (int i = 0; i < RT; ++i) {
    int m = m0 + i, t = m - sbase;
    const u16* pr = P.p + (size_t)m * LDP + OFF_C + ch;
    bool hp = t > 0, hn = t < T - 1;
    float rv[2], kv[2], vv[2];
#pragma unroll
    for (int part = 0; part < 3; ++part) {
      unsigned u = *reinterpret_cast<const unsigned*>(pr + part * 512);
      unsigned pu = hp ? *reinterpret_cast<const unsigned*>(pr - LDP + part * 512) : 0u;
      unsigned nu = hn ? *reinterpret_cast<const unsigned*>(pr + LDP + part * 512) : 0u;
#pragma unroll
      for (int j = 0; j < 2; ++j) {
        float uu = bf2f((u16)(u >> (16 * j))), pp = bf2f((u16)(pu >> (16 * j))), nn = bf2f((u16)(nu >> (16 * j)));
        float muj = part == 0 ? mur[j] : (part == 1 ? muk[j] : muv[j]);
        float val = uu + muj * (0.5f * (pp + nn) - uu);
        if (part == 0) rv[j] = val; else if (part == 1) kv[j] = val; else vv[j] = val;
      }
    }
    float accs[2][5] = {{awf[i].x, awb[i].x, aaf[i].x, aab[i].x, ag[i].x}, {awf[i].y, awb[i].y, aaf[i].y, aab[i].y, ag[i].y}};
    float kkf[2], ssq = 0.f;
#pragma unroll
    for (int j = 0; j < 2; ++j) { kkf[j] = kv[j] * kkc[j]; ssq += kkf[j] * kkf[j]; }
    ssq = group_sum<32>(ssq);
    float rn = rsqrtf(ssq + 1e-12f);
    float bon = 0.f;
    float o_dec[2][2], o_kd[2][2], o_bk[2][2], o_nkk[2];
#pragma unroll
    for (int j = 0; j < 2; ++j) {
      float kk = kkf[j] * rn;
      o_nkk[j] = -kk;
#pragma unroll
      for (int d = 0; d < 2; ++d) {
        float wl = (d ? w0b[j] : w0f[j]) + accs[j][d];
        float dec = __expf(-__expf(-softplusf_(-wl) - 0.5f));
        float a = sigmoidf_((d ? a0b[j] : a0f[j]) + accs[j][2 + d]);
        float kd = kv[j] * (1.f + (a - 1.f) * kac[j]);
        o_dec[d][j] = dec; o_kd[d][j] = kd; o_bk[d][j] = kk * a;
        bon += rv[j] * kd * rkc[j];
      }
    }
    bon = group_sum<32>(bon);
    size_t o = (size_t)m * 512 + ch;
    *reinterpret_cast<float2*>(P.rr + o) = make_float2(rv[0], rv[1]);
    *reinterpret_cast<float2*>(P.rv + o) = make_float2(vv[0], vv[1]);
    *reinterpret_cast<float2*>(P.rnkk + o) = make_float2(o_nkk[0], o_nkk[1]);
    *reinterpret_cast<float2*>(P.rgc + o) = make_float2(accs[0][4], accs[1][4]);
#pragma unroll
    for (int d = 0; d < 2; ++d) {
      size_t od = (size_t)d * NTOK * 512 + o;
      *reinterpret_cast<float2*>(P.rdec + od) = make_float2(o_dec[d][0], o_dec[d][1]);
      *reinterpret_cast<float2*>(P.rkd + od) = make_float2(o_kd[d][0], o_kd[d][1]);
      *reinterpret_cast<float2*>(P.rbk + od) = make_float2(o_bk[d][0], o_bk[d][1]);
    }
    if ((tid & 31) == 0) P.rbon[(size_t)m * 8 + (tid >> 5)] = bon;
  }
}

__device__ __forceinline__ void attn_item(const Params& P, int layer, int it) {
  int lane = ltid() & 63, wave = ltid() >> 6;
  int nkeys, qtok, head;
  const u16 *kb, *vt;
  if (it < 128) {
    int b = it >> 6, qb = it & 7; head = (it >> 3) & 7;
    int kvh = head >> 2;
    nkeys = 1280;
    qtok = NCTX + b * 1024 + qb * 128;
    size_t hb = ((size_t)(layer * 2 + b) * 2 + kvh);
    kb = P.klat + hb * 1280 * 64;
    vt = P.vtlat + hb * 64 * 1280;
  } else {
    int j = it - 128;
    int b = j >> 4, qb = j & 1; head = (j >> 1) & 7;
    int kvh = head >> 2;
    nkeys = 256;
    qtok = b * 256 + qb * 128;
    kb = P.kctx + (size_t)(b * 2 + kvh) * 256 * 64;
    vt = P.vtctx + (size_t)(b * 2 + kvh) * 64 * 256;
  }
  int q0 = qtok + wave * 32;
  int r31 = lane & 31, hh = lane >> 5;
  bf16x8 qf[4];
  {
    const u16* qp = P.qbuf + (size_t)(q0 + r31) * 512 + head * 64 + hh * 8;
#pragma unroll
    for (int ks = 0; ks < 4; ++ks) qf[ks] = ld8(qp + ks * 16);
  }
  f32x16 o[2];
  o[0] = zero16(); o[1] = zero16();
  float mrun = -1e30f, lrun = 0.f;
  for (int kt = 0; kt < nkeys; kt += 64) {
    f32x16 x[2];
#pragma unroll
    for (int sub = 0; sub < 2; ++sub) {
      x[sub] = zero16();
      const u16* kp = kb + (size_t)(kt + sub * 32 + r31) * 64 + hh * 8;
#pragma unroll
      for (int ks = 0; ks < 4; ++ks) x[sub] = mfma(ld8(kp + ks * 16), qf[ks], x[sub]);
    }
    float mx = -1e30f;
#pragma unroll
    for (int sub = 0; sub < 2; ++sub)
#pragma unroll
      for (int r = 0; r < 16; ++r) mx = fmaxf(mx, x[sub][r]);
    mx = fmaxf(mx, __shfl_xor(mx, 32, 64));
    float mnew = fmaxf(mrun, mx * 0.125f);
    float alpha = __expf(mrun - mnew);
    mrun = mnew;
    float psum = 0.f;
    bf16x8 pf[2][2];
#pragma unroll
    for (int sub = 0; sub < 2; ++sub)
#pragma unroll
      for (int r = 0; r < 16; ++r) {
        float pv = __expf(x[sub][r] * 0.125f - mnew);
        psum += pv;
        pf[sub][r >> 3][r & 7] = (short)f2bf(pv);
      }
    lrun = lrun * alpha + psum;
#pragma unroll
    for (int dt = 0; dt < 2; ++dt) {
#pragma unroll
      for (int r = 0; r < 16; ++r) o[dt][r] *= alpha;
      const u16* vp = vt + (size_t)(dt * 32 + r31) * nkeys + kt + 4 * hh;
#pragma unroll
      for (int sub = 0; sub < 2; ++sub)
#pragma unroll
        for (int s = 0; s < 2; ++s) {
          bf16x8 vf = ld4x2(vp + sub * 32 + 16 * s, vp + sub * 32 + 16 * s + 8);
          o[dt] = mfma(vf, pf[sub][s], o[dt]);
        }
    }
  }
  lrun += __shfl_xor(lrun, 32, 64);
  float inv = 1.f / lrun;
  u16* op = P.ocat + (size_t)(q0 + r31) * 1536 + head * 64;
#pragma unroll
  for (int dt = 0; dt < 2; ++dt)
#pragma unroll
    for (int g = 0; g < 4; ++g) {
      int d = dt * 32 + 8 * g + 4 * hh;
      uint2 w;
      w.x = pack2(o[dt][4 * g + 0] * inv, o[dt][4 * g + 1] * inv);
      w.y = pack2(o[dt][4 * g + 2] * inv, o[dt][4 * g + 3] * inv);
      *reinterpret_cast<uint2*>(op + d) = w;
    }
}

__device__ __forceinline__ void gla_scan_item(const Params& P, int layer, int it) {
  int lane = ltid() & 63, wave = ltid() >> 6;
  int s, h, dir;
  if (it < 16) { s = 16 + (it >> 3); h = (it >> 1) & 3; dir = it & 1; }
  else { int j = it - 16; s = j >> 3; h = (j >> 1) & 3; dir = j & 1; }
  int sbase, T;
  seq_info(s, sbase, T);
  int nch = T >> 6;
  int r31 = lane & 31, hh = lane >> 5;
  int dv = wave * 32 + r31;
  f32x16 S[2];
  if (s >= 16) {
    const float* sp = P.in[I_SG] + ((((size_t)(s - 16) * 4 + layer) * 2 + dir) * 4 + h) * 64 * 128;
#pragma unroll
    for (int d2 = 0; d2 < 2; ++d2)
#pragma unroll
      for (int r = 0; r < 16; ++r) S[d2][r] = sp[(size_t)(d2 * 32 + accrow(r, hh)) * 128 + dv];
  } else { S[0] = zero16(); S[1] = zero16(); }
  const u16* qeb = P.gqe + (size_t)dir * NTOK * 256 + h * 64;
  const u16* keb = P.gke + (size_t)dir * NTOK * 256 + h * 64;
  float* ob = P.ob + (size_t)dir * NTOK * 512 + h * 128 + dv;
#pragma unroll 1
  for (int cs = 0; cs < nch; ++cs) {
    int ctok = dir ? nch - 1 - cs : cs;
    int m0 = sbase + ctok * 64;
    int gchunk = m0 >> 6;
    int tokA0 = m0 + (dir ? 63 - r31 : r31);
    int tokA1 = m0 + (dir ? 63 - (32 + r31) : 32 + r31);
    const u16* vT = P.gvT + ((((size_t)dir * 96 + gchunk) * 4 + h) * 128 + dv) * 64;
    const u16* klT = P.gklT + ((((size_t)dir * 96 + gchunk) * 4 + h) * 64) * 64;
    f32x16 X00 = zero16(), X01 = zero16(), X11 = zero16();
#pragma unroll
    for (int ks = 0; ks < 4; ++ks) {
      bf16x8 k0 = ld8(keb + (size_t)tokA0 * 256 + ks * 16 + hh * 8);
      bf16x8 k1 = ld8(keb + (size_t)tokA1 * 256 + ks * 16 + hh * 8);
      bf16x8 q0 = ld8(qeb + (size_t)tokA0 * 256 + ks * 16 + hh * 8);
      bf16x8 q1 = ld8(qeb + (size_t)tokA1 * 256 + ks * 16 + hh * 8);
      X00 = mfma(k0, q0, X00);
      X01 = mfma(k0, q1, X01);
      X11 = mfma(k1, q1, X11);
    }
#pragma unroll
    for (int r = 0; r < 16; ++r) {
      bool keep = accrow(r, hh) <= r31;
      X00[r] = keep ? X00[r] : 0.f;
      X11[r] = keep ? X11[r] : 0.f;
    }
#pragma unroll 1
    for (int tt = 0; tt < 2; ++tt) {
      f32x16 O = zero16();
      int tokq = tt ? tokA1 : tokA0;
#pragma unroll
      for (int d2 = 0; d2 < 2; ++d2)
#pragma unroll
        for (int sx = 0; sx < 2; ++sx) {
          const u16* qp = qeb + (size_t)tokq * 256 + d2 * 32 + 16 * sx + 4 * hh;
          O = mfma(ld4x2(qp, qp + 8), acc2frag(S[d2], sx), O);
        }
#pragma unroll
      for (int sx = 0; sx < 2; ++sx) {
        const u16* vp = vT + 16 * sx + 4 * hh;
        bf16x8 v0 = ld4x2(vp, vp + 8);
        if (tt == 0) {
          O = mfma(acc2frag(X00, sx), v0, O);
        } else {
          bf16x8 v1 = ld4x2(vp + 32, vp + 40);
          O = mfma(acc2frag(X01, sx), v0, O);
          O = mfma(acc2frag(X11, sx), v1, O);
        }
      }
#pragma unroll
      for (int r = 0; r < 16; ++r) {
        int i = tt * 32 + accrow(r, hh);
        int tok = m0 + (dir ? 63 - i : i);
        ob[(size_t)tok * 512] = O[r];
      }
    }
    const float* dl = P.gdl + ((size_t)dir * 96 + gchunk) * 256 + h * 64;
#pragma unroll
    for (int d2 = 0; d2 < 2; ++d2) {
#pragma unroll
      for (int g = 0; g < 4; ++g) {
        float4 dv4 = *reinterpret_cast<const float4*>(dl + d2 * 32 + 8 * g + 4 * hh);
        S[d2][4 * g + 0] *= dv4.x; S[d2][4 * g + 1] *= dv4.y; S[d2][4 * g + 2] *= dv4.z; S[d2][4 * g + 3] *= dv4.w;
      }
#pragma unroll
      for (int ks = 0; ks < 4; ++ks) {
        bf16x8 a = ld8(klT + (size_t)(d2 * 32 + r31) * 64 + ks * 16 + hh * 8);
        bf16x8 b = ld8(vT + ks * 16 + hh * 8);
        S[d2] = mfma(a, b, S[d2]);
      }
    }
  }
  if (s < 16) {
    float* sp = P.out + O_SG + ((((size_t)s * 4 + layer) * 2 + dir) * 4 + h) * 64 * 128;
#pragma unroll
    for (int d2 = 0; d2 < 2; ++d2)
#pragma unroll
      for (int r = 0; r < 16; ++r) sp[(size_t)(d2 * 32 + accrow(r, hh)) * 128 + dv] = S[d2][r];
  }
}

__device__ __forceinline__ void rwkv_scan_item(const Params& P, int layer, int it, char* smem) {
  int tid = ltid(), lane = tid & 63, wave = tid >> 6;
  int s, h, dir, rb;
  if (it < 128) { s = 16 + (it >> 6); h = (it >> 3) & 7; dir = (it >> 2) & 1; rb = it & 3; }
  else { int j = it - 128; s = j >> 6; h = (j >> 3) & 7; dir = (j >> 2) & 1; rb = j & 3; }
  int sbase, T;
  seq_info(s, sbase, T);
  int lrow = wave * 4 + (lane >> 4);
  int row = rb * 16 + lrow;
  int c0 = (lane & 15) * 4;
  float4 S = make_float4(0.f, 0.f, 0.f, 0.f);
  if (s >= 16)
    S = *reinterpret_cast<const float4*>(P.in[I_SR] + (((((size_t)(s - 16) * 4 + layer) * 2 + dir) * 8 + h) * 64 + row) * 64 + c0);
  constexpr int BUF = 5 * 1024 + 256;
  float* buf = (float*)smem;
  const int lst = tid >> 4, lc4 = (tid & 15) * 4, lrr = tid & 15;
  const float* gR = P.rr + h * 64;
  const float* gW = P.rdec + (size_t)dir * NTOK * 512 + h * 64;
  const float* gK = P.rkd + (size_t)dir * NTOK * 512 + h * 64;
  const float* gA = P.rnkk + h * 64;
  const float* gB = P.rbk + (size_t)dir * NTOK * 512 + h * 64;
  const float* gV = P.rv + h * 64 + rb * 16;
  float* yo = P.ry + (size_t)dir * NTOK * 512 + h * 64 + row;
  float4 pr, pw, pk, pa, pb; float pv;
  __syncthreads();
  {
    int tok = sbase + (dir ? T - 1 - lst : lst);
    size_t o = (size_t)tok * 512;
    pr = *reinterpret_cast<const float4*>(gR + o + lc4);
    pw = *reinterpret_cast<const float4*>(gW + o + lc4);
    pk = *reinterpret_cast<const float4*>(gK + o + lc4);
    pa = *reinterpret_cast<const float4*>(gA + o + lc4);
    pb = *reinterpret_cast<const float4*>(gB + o + lc4);
    pv = gV[o + lrr];
    float* bw = buf;
    *reinterpret_cast<float4*>(bw + 0 * 1024 + lst * 64 + lc4) = pr;
    *reinterpret_cast<float4*>(bw + 1 * 1024 + lst * 64 + lc4) = pw;
    *reinterpret_cast<float4*>(bw + 2 * 1024 + lst * 64 + lc4) = pk;
    *reinterpret_cast<float4*>(bw + 3 * 1024 + lst * 64 + lc4) = pa;
    *reinterpret_cast<float4*>(bw + 4 * 1024 + lst * 64 + lc4) = pb;
    bw[5 * 1024 + lst * 16 + lrr] = pv;
  }
  __syncthreads();
  int nch = T >> 4;
  for (int ch = 0; ch < nch; ++ch) {
    int cur = ch & 1;
    if (ch + 1 < nch) {
      int si = (ch + 1) * 16 + lst;
      int tok = sbase + (dir ? T - 1 - si : si);
      size_t o = (size_t)tok * 512;
      pr = *reinterpret_cast<const float4*>(gR + o + lc4);
      pw = *reinterpret_cast<const float4*>(gW + o + lc4);
      pk = *reinterpret_cast<const float4*>(gK + o + lc4);
      pa = *reinterpret_cast<const float4*>(gA + o + lc4);
      pb = *reinterpret_cast<const float4*>(gB + o + lc4);
      pv = gV[o + lrr];
    }
    const float* bb = buf + cur * BUF;
#pragma unroll 4
    for (int st = 0; st < 16; ++st) {
      float4 r4 = *reinterpret_cast<const float4*>(bb + 0 * 1024 + st * 64 + c0);
      float4 w4 = *reinterpret_cast<const float4*>(bb + 1 * 1024 + st * 64 + c0);
      float4 k4 = *reinterpret_cast<const float4*>(bb + 2 * 1024 + st * 64 + c0);
      float4 a4 = *reinterpret_cast<const float4*>(bb + 3 * 1024 + st * 64 + c0);
      float4 b4 = *reinterpret_cast<const float4*>(bb + 4 * 1024 + st * 64 + c0);
      float vv = bb[5 * 1024 + st * 16 + lrow];
      float sa = S.x * a4.x + S.y * a4.y + S.z * a4.z + S.w * a4.w;
      sa = group_sum<16>(sa);
      S.x = S.x * w4.x + sa * b4.x + vv * k4.x;
      S.y = S.y * w4.y + sa * b4.y + vv * k4.y;
      S.z = S.z * w4.z + sa * b4.z + vv * k4.z;
      S.w = S.w * w4.w + sa * b4.w + vv * k4.w;
      float y = S.x * r4.x + S.y * r4.y + S.z * r4.z + S.w * r4.w;
      y = group_sum<16>(y);
      if ((lane & 15) == 0) {
        int si = ch * 16 + st;
        int tok = sbase + (dir ? T - 1 - si : si);
        yo[(size_t)tok * 512] = y;
      }
    }
    if (ch + 1 < nch) {
      float* bw = buf + (cur ^ 1) * BUF;
      *reinterpret_cast<float4*>(bw + 0 * 1024 + lst * 64 + lc4) = pr;
      *reinterpret_cast<float4*>(bw + 1 * 1024 + lst * 64 + lc4) = pw;
      *reinterpret_cast<float4*>(bw + 2 * 1024 + lst * 64 + lc4) = pk;
      *reinterpret_cast<float4*>(bw + 3 * 1024 + lst * 64 + lc4) = pa;
      *reinterpret_cast<float4*>(bw + 4 * 1024 + lst * 64 + lc4) = pb;
      bw[5 * 1024 + lst * 16 + lrr] = pv;
    }
    __syncthreads();
  }
  if (s < 16)
    *reinterpret_cast<float4*>(P.out + O_SR + (((((size_t)s * 4 + layer) * 2 + dir) * 8 + h) * 64 + row) * 64 + c0) = S;
}

__device__ __forceinline__ void post_item(const Params& P, int layer, int it) {
  int lane = ltid() & 63, wave = ltid() >> 6;
  int m = it * 4 + wave;
  {
    const float* a = P.ob + (size_t)m * 512 + lane * 8;
    const float* b = a + (size_t)NTOK * 512;
    float v[8];
    float4 a0 = *reinterpret_cast<const float4*>(a), a1 = *reinterpret_cast<const float4*>(a + 4);
    float4 b0 = *reinterpret_cast<const float4*>(b), b1 = *reinterpret_cast<const float4*>(b + 4);
    v[0] = a0.x + b0.x; v[1] = a0.y + b0.y; v[2] = a0.z + b0.z; v[3] = a0.w + b0.w;
    v[4] = a1.x + b1.x; v[5] = a1.y + b1.y; v[6] = a1.z + b1.z; v[7] = a1.w + b1.w;
    float ss = 0.f;
#pragma unroll
    for (int i = 0; i < 8; ++i) ss += v[i] * v[i];
    ss = group_sum<16>(ss);
    float rs = rsqrtf(ss * (1.f / 128.f) + 1e-6f);
    float gb[8];
    unpack8(*reinterpret_cast<const uint4*>(P.p + (size_t)m * LDP + OFF_GB + lane * 8), gb);
#pragma unroll
    for (int i = 0; i < 8; ++i) v[i] = v[i] * rs * P.in[I_GLAG][layer * 128 + (lane & 15) * 8 + i] * siluf_(gb[i]);
    *reinterpret_cast<uint4*>(P.ocat + (size_t)m * 1536 + 512 + lane * 8) = pack8(v);
  }
  {
    const float* a = P.ry + (size_t)m * 512 + lane * 8;
    const float* b = a + (size_t)NTOK * 512;
    float v[8];
    float4 a0 = *reinterpret_cast<const float4*>(a), a1 = *reinterpret_cast<const float4*>(a + 4);
    float4 b0 = *reinterpret_cast<const float4*>(b), b1 = *reinterpret_cast<const float4*>(b + 4);
    v[0] = a0.x + b0.x; v[1] = a0.y + b0.y; v[2] = a0.z + b0.z; v[3] = a0.w + b0.w;
    v[4] = a1.x + b1.x; v[5] = a1.y + b1.y; v[6] = a1.z + b1.z; v[7] = a1.w + b1.w;
    float sm = 0.f;
#pragma unroll
    for (int i = 0; i < 8; ++i) sm += v[i];
    sm = group_sum<8>(sm);
    float mean = sm * (1.f / 64.f);
    float vs = 0.f;
#pragma unroll
    for (int i = 0; i < 8; ++i) { float dd = v[i] - mean; vs += dd * dd; }
    vs = group_sum<8>(vs);
    float rs = rsqrtf(vs * (1.f / 64.f) + 64e-5f);
    float bon = P.rbon[(size_t)m * 8 + (lane >> 3)];
    int c = lane * 8;
    const float* vc = P.rv + (size_t)m * 512 + c;
    const float* gc = P.rgc + (size_t)m * 512 + c;
#pragma unroll
    for (int i = 0; i < 8; ++i) {
      float gn = (v[i] - mean) * rs * P.in[I_LNW][layer * 512 + c + i] + P.in[I_LNB][layer * 512 + c + i];
      v[i] = (gn + bon * vc[i]) * gc[i];
    }
    *reinterpret_cast<uint4*>(P.ocat + (size_t)m * 1536 + 1024 + c) = pack8(v);
  }
}

constexpr int N_PHASES = 1 + 10 * DEPTH;

__device__ __forceinline__ void run_phase(const Params& P, int layer, int sub, char* smem) {
  const int G = gridDim.x, b = lbid();
  if (sub < 0) {
    const int total = 384 + CV_TOTAL + 1024;
    for (int it = b; it < total; it += G) {
      if (it < 384) adaln_item(P, it, smem);
      else if (it < 384 + CV_TOTAL) convert_item(P, 0, it - 384, smem);
      else cache_item(P, it - 384 - CV_TOTAL);
    }
    return;
  }
  switch (sub) {
    case 0: for (int it = b; it < NTOK / 4; it += G) norm_item(P, layer, 0, it); break;
    case 1: gemm_in_phase(P, layer, smem); break;
    case 2: {
      const int n1 = NTOK / RT, n2 = 384, n3 = NTOK / 4;
      for (int it = b; it < n1 + n2 + n3; it += G) {
        if (it < n1) rwkv_prep_item(P, layer, it, smem);
        else if (it < n1 + n2) gla_prep_item(P, layer, it - n1, smem);
        else attn_prep_item(P, layer, it - n1 - n2);
      }
    } break;
    case 3: {
      const int ncv = (layer + 1 < DEPTH) ? CV_TOTAL : 0;
      const int total = 128 + 16 + 128 + 1024 + 128 + 256 + ncv;
      int rounds = (total + G - 1) / G;
      for (int k = 0; k < rounds; ++k) {
        int it = k * G + ((k & 1) ? (G - 1 - b) : b);
        if (it >= total) continue;
        if (it < 128) rwkv_scan_item(P, layer, it, smem);
        else if (it < 144) gla_scan_item(P, layer, it - 128);
        else if (it < 272) attn_item(P, layer, it - 144);
        else if (it < 1296) rwkv_scan_item(P, layer, it - 272 + 128, smem);
        else if (it < 1424) gla_scan_item(P, layer, it - 1296 + 16);
        else if (it < 1680) attn_item(P, layer, it - 1424 + 128);
        else convert_item(P, layer + 1, it - 1680, smem);
      }
    } break;
    case 4: for (int it = b; it < NTOK / 4; it += G) post_item(P, layer, it); break;
    case 5: gemm_po_phase(P, layer, smem); break;
    case 6: gemm_res_phase(P, layer, 0, smem); break;
    case 7: for (int it = b; it < NTOK / 4; it += G) norm_item(P, layer, 1, it); break;
    case 8: gemm_ffi_phase(P, layer, smem); break;
    case 9: gemm_res_phase(P, layer, 1, smem); break;
  }
}

#if !MEGA
template <int SUB>
__global__ void __launch_bounds__(NTHREADS, 2) phase_kernel(Params P, int layer) {
  __shared__ __attribute__((aligned(16))) char smem[65536];
  run_phase(P, layer, SUB, smem);
}
#else
__global__ void __launch_bounds__(NTHREADS, 2) mega_kernel(Params P) {
  __shared__ __attribute__((aligned(16))) char smem[65536];
  cg::grid_group grid = cg::this_grid();
  for (int ph = 0; ph < N_PHASES; ++ph) {
    int layer = (ph == 0) ? 0 : (ph - 1) / 10;
    int sub = (ph == 0) ? -1 : (ph - 1) % 10;
    run_phase(P, layer, sub, smem);
    if (ph + 1 < N_PHASES) grid.sync();
  }
}
#endif

extern "C" void kernel_launch(void* const* d_in, const int* in_sizes, int n_in, void* d_out, int out_size, void* d_ws,
                              size_t ws_size, hipStream_t stream) {
  Params P{};
  for (int i = 0; i < N_INPUTS; ++i) P.in[i] = (const float*)d_in[i];
  P.out = (float*)d_out;
  char* w = (char*)d_ws;
  size_t off = 0;
  auto alloc = [&](size_t bytes) { char* r = w + off; off += (bytes + 255) & ~(size_t)255; return r; };
  P.wb[0] = (u16*)alloc(WB_TOTAL * 2);
  P.wb[1] = (u16*)alloc(WB_TOTAL * 2);
  P.mod = (float*)alloc((size_t)4 * 3 * 6144 * 4);
  P.h = (u16*)alloc((size_t)NTOK * D * 2);
  P.p = (u16*)alloc((size_t)NTOK * LDP * 2);
  P.qbuf = (u16*)alloc((size_t)NTOK * 512 * 2);
  P.kctx = (u16*)alloc((size_t)16 * 2 * 256 * 64 * 2);
  P.vtctx = (u16*)alloc((size_t)16 * 2 * 64 * 256 * 2);
  P.klat = (u16*)alloc((size_t)4 * 2 * 2 * 1280 * 64 * 2);
  P.vtlat = (u16*)alloc((size_t)4 * 2 * 2 * 64 * 1280 * 2);
  P.gqe = (u16*)alloc((size_t)2 * NTOK * 256 * 2);
  P.gke = (u16*)alloc((size_t)2 * NTOK * 256 * 2);
  P.gklT = (u16*)alloc((size_t)2 * 96 * 4 * 64 * 64 * 2);
  P.gvT = (u16*)alloc((size_t)2 * 96 * 4 * 128 * 64 * 2);
  P.gdl = (float*)alloc((size_t)2 * 96 * 256 * 4);
  P.ob = (float*)alloc((size_t)2 * NTOK * 512 * 4);
  P.rr = (float*)alloc((size_t)NTOK * 512 * 4);
  P.rv = (float*)alloc((size_t)NTOK * 512 * 4);
  P.rnkk = (float*)alloc((size_t)NTOK * 512 * 4);
  P.rdec = (float*)alloc((size_t)2 * NTOK * 512 * 4);
  P.rkd = (float*)alloc((size_t)2 * NTOK * 512 * 4);
  P.rbk = (float*)alloc((size_t)2 * NTOK * 512 * 4);
  P.rgc = (float*)alloc((size_t)NTOK * 512 * 4);
  P.rbon = (float*)alloc((size_t)NTOK * 8 * 4);
  P.ry = (float*)alloc((size_t)2 * NTOK * 512 * 4);
  P.ocat = (u16*)alloc((size_t)NTOK * 1536 * 2);
  if (off > ws_size) { fprintf(stderr, "workspace too small: need %zu have %zu\n", off, ws_size); return; }

  static int grid_blocks = 0;
  if (!grid_blocks) {
    int dev = 0, cus = 0, per_cu = 0;
    hipGetDevice(&dev);
    hipDeviceGetAttribute(&cus, hipDeviceAttributeMultiprocessorCount, dev);
#if MEGA
    hipOccupancyMaxActiveBlocksPerMultiprocessor(&per_cu, mega_kernel, NTHREADS, 0);
#else
    hipOccupancyMaxActiveBlocksPerMultiprocessor(&per_cu, phase_kernel<1>, NTHREADS, 0);
#endif
    if (per_cu < 1) per_cu = 1;
    if (per_cu > 2) per_cu = 2;
    grid_blocks = cus * per_cu;
  }
#if MEGA
  void* args[] = {&P};
  hipError_t e = hipLaunchCooperativeKernel((void*)mega_kernel, dim3(grid_blocks), dim3(NTHREADS), args, 0, stream);
  if (e != hipSuccess) fprintf(stderr, "cooperative launch failed: %s (grid %d)\n", hipGetErrorString(e), grid_blocks);
#else
  phase_kernel<-1><<<grid_blocks, NTHREADS, 0, stream>>>(P, 0);
  for (int l = 0; l < DEPTH; ++l) {
    phase_kernel<0><<<grid_blocks, NTHREADS, 0, stream>>>(P, l);
    phase_kernel<1><<<grid_blocks, NTHREADS, 0, stream>>>(P, l);
    phase_kernel<2><<<grid_blocks, NTHREADS, 0, stream>>>(P, l);
    phase_kernel<3><<<grid_blocks, NTHREADS, 0, stream>>>(P, l);
    phase_kernel<4><<<grid_blocks, NTHREADS, 0, stream>>>(P, l);
    phase_kernel<5><<<grid_blocks, NTHREADS, 0, stream>>>(P, l);
    phase_kernel<6><<<grid_blocks, NTHREADS, 0, stream>>>(P, l);
    phase_kernel<7><<<grid_blocks, NTHREADS, 0, stream>>>(P, l);
    phase_kernel<8><<<grid_blocks, NTHREADS, 0, stream>>>(P, l);
    phase_kernel<9><<<grid_blocks, NTHREADS, 0, stream>>>(P, l);
  }
#endif
}
```

```cpp
#include <hip/hip_runtime.h>
#include <hip/hip_cooperative_groups.h>
#include <stdint.h>
#include <cstdio>
namespace cg = cooperative_groups;

#ifndef PROBE_SYNCN
#define PROBE_SYNCN 1
#endif
#ifndef PROBE_C
#define PROBE_C 0
#endif
#ifndef PROBE_D
#define PROBE_D 0
#endif
#ifndef PROBE_DUP
#define PROBE_DUP 0
#endif
#ifndef MEGA
#define MEGA 1
#endif

typedef unsigned short u16;
typedef __attribute__((ext_vector_type(8))) short bf16x8;
typedef __attribute__((ext_vector_type(4))) short bf16x4;
typedef __attribute__((ext_vector_type(16))) float f32x16;

constexpr int D = 1024;
constexpr int NTOK = 6144;
constexpr int NCTX = 4096;
constexpr int DEPTH = 4;
constexpr int NIN = 7328;
constexpr int LDP = 7424;
constexpr int DFF = 2816;
constexpr int OFF_KA = 512, OFF_VA = 640, OFF_QB = 768, OFF_KB = 1024, OFF_VB = 1280, OFF_GB = 1792,
              OFF_GKF = 2304, OFF_GKB = 2320, OFF_C = 2336, OFF_GATE = 4256;
constexpr int NTHREADS = 256;

enum { I_XP = 0, I_XS, I_CK, I_CV, I_SG, I_SR, I_C, I_CCTX, I_WADA, I_BADA, I_GMIX, I_GFFN, I_WIN, I_QG, I_KG,
       I_GKW2, I_GKB, I_GLAG, I_MU, I_W0, I_W2, I_A0, I_A2, I_G2, I_KK, I_KA, I_RK, I_LNW, I_LNB,
       I_WPA, I_WPB, I_WPC, I_WOUT, I_WFI, I_WFO, N_INPUTS };

constexpr size_t O_YP = 0, O_YS = 4194304, O_CK = 6291456, O_CV = 8388608, O_SG = 10485760, O_SR = 14680064;

constexpr size_t WB_IN = 0;
constexpr size_t WB_PO = WB_IN + (size_t)LDP * 1024;
constexpr size_t WB_OUT = WB_PO + (size_t)3 * 1024 * 512;
constexpr size_t WB_FI = WB_OUT + (size_t)1024 * 1024;
constexpr size_t WB_FO = WB_FI + (size_t)5632 * 1024;
constexpr size_t WB_LORA = WB_FO + (size_t)1024 * 2816;
constexpr size_t WB_TOTAL = WB_LORA + (size_t)4 * 32768 + 65536;

struct Params {
  const float* in[N_INPUTS];
  float* out;
  u16* wb[2];
  float* mod;
  u16* h;
  u16* p;
  u16* qbuf;
  u16* kctx;
  u16* vtctx;
  u16* klat;
  u16* vtlat;
  u16* gqe;
  u16* gke;
  u16* gklT;
  u16* gvT;
  float* gdl;
  u16* ob;
  u16* obi;
  float* gU;
  u16* rr;
  u16* rv;
  u16* rnkk;
  float* rdec;
  u16* rkd;
  u16* rbk;
  u16* rgc;
  float* rbon;
  float* ry;
  u16* ocat;
  unsigned* bar;
};

__device__ __forceinline__ int ltid() { int t = threadIdx.x; asm volatile("" : "+v"(t)); return t; }
__device__ __forceinline__ int lbid() { int t = blockIdx.x; asm volatile("" : "+s"(t)); return t; }
__device__ __forceinline__ u16 f2bf(float f) {
  unsigned u = __float_as_uint(f);
  u += 0x7fffu + ((u >> 16) & 1u);
  return (u16)(u >> 16);
}
__device__ __forceinline__ float bf2f(u16 b) { return __uint_as_float(((unsigned)b) << 16); }
__device__ __forceinline__ unsigned pack2(float a, float b) { return (unsigned)f2bf(a) | ((unsigned)f2bf(b) << 16); }
__device__ __forceinline__ float sigmoidf_(float x) { return __builtin_amdgcn_rcpf(1.f + __expf(-x)); }
__device__ __forceinline__ float siluf_(float x) { return x * __builtin_amdgcn_rcpf(1.f + __expf(-x)); }
__device__ __forceinline__ float softplusf_(float x) { return fmaxf(x, 0.f) + log1pf(__expf(-fabsf(x))); }

template <int CTRL>
__device__ __forceinline__ float dpp_addf(float x) {
  int xi = __float_as_int(x);
  int yi = __builtin_amdgcn_update_dpp(0, xi, CTRL, 0xF, 0xF, true);
  return x + __int_as_float(yi);
}
template <int N>
__device__ __forceinline__ float group_sum(float x) {
  x = dpp_addf<0xB1>(x);
  x = dpp_addf<0x4E>(x);
  x = dpp_addf<0x141>(x);
  if (N >= 16) x = dpp_addf<0x140>(x);
  if (N >= 32) x += __shfl_xor(x, 16, 64);
  if (N >= 64) x += __shfl_xor(x, 32, 64);
  return x;
}

__device__ __forceinline__ void unpack8(uint4 r, float* v) {
  v[0] = __uint_as_float(r.x << 16); v[1] = __uint_as_float(r.x & 0xffff0000u);
  v[2] = __uint_as_float(r.y << 16); v[3] = __uint_as_float(r.y & 0xffff0000u);
  v[4] = __uint_as_float(r.z << 16); v[5] = __uint_as_float(r.z & 0xffff0000u);
  v[6] = __uint_as_float(r.w << 16); v[7] = __uint_as_float(r.w & 0xffff0000u);
}
__device__ __forceinline__ uint4 pack8(const float* v) {
  uint4 r; r.x = pack2(v[0], v[1]); r.y = pack2(v[2], v[3]); r.z = pack2(v[4], v[5]); r.w = pack2(v[6], v[7]);
  return r;
}
__device__ __forceinline__ float4 unpack4(uint2 r) {
  return make_float4(__uint_as_float(r.x << 16), __uint_as_float(r.x & 0xffff0000u), __uint_as_float(r.y << 16),
                     __uint_as_float(r.y & 0xffff0000u));
}
__device__ __forceinline__ uint2 pack4(float a, float b, float c, float d) { uint2 r; r.x = pack2(a, b); r.y = pack2(c, d); return r; }
__device__ __forceinline__ f32x16 zero16() {
  f32x16 z;
#pragma unroll
  for (int i = 0; i < 16; ++i) z[i] = 0.f;
  return z;
}
__device__ __forceinline__ f32x16 mfma(bf16x8 a, bf16x8 b, f32x16 c) {
  return __builtin_amdgcn_mfma_f32_32x32x16_bf16(a, b, c, 0, 0, 0);
}
__device__ __forceinline__ int accrow(int r, int h) { return (r & 3) + 8 * (r >> 2) + 4 * h; }

__device__ __forceinline__ bf16x8 ld8(const u16* p) { return *reinterpret_cast<const bf16x8*>(p); }
__device__ __forceinline__ bf16x8 ld4x2(const u16* p0, const u16* p1) {
  bf16x4 a = *reinterpret_cast<const bf16x4*>(p0);
  bf16x4 b = *reinterpret_cast<const bf16x4*>(p1);
  bf16x8 r;
  r[0] = a[0]; r[1] = a[1]; r[2] = a[2]; r[3] = a[3]; r[4] = b[0]; r[5] = b[1]; r[6] = b[2]; r[7] = b[3];
  return r;
}
__device__ __forceinline__ bf16x8 acc2frag(const f32x16& x, int s) {
  bf16x8 r;
#pragma unroll
  for (int j = 0; j < 8; ++j) r[j] = (short)f2bf(x[8 * s + j]);
  return r;
}

__device__ __forceinline__ void seq_info(int s, int& base, int& T) {
  if (s < 16) { base = s * 256; T = 256; } else { base = NCTX + (s - 16) * 1024; T = 1024; }
}
__device__ __forceinline__ int cond_of(int m) { return m < NCTX ? 0 : 1 + ((m - NCTX) >> 10); }

__device__ __forceinline__ void convert_tile(const float* __restrict__ src, int Nsrc, u16* __restrict__ dst, int K, int kt, int nt,
                             int kind, char* smem) {
  float* tile = (float*)smem;
  int tid = ltid();
  __syncthreads();
#pragma unroll
  for (int pss = 0; pss < 4; ++pss) {
    int kr = pss * 16 + (tid >> 4);
    int nl = (tid & 15) * 4;
    int scol;
    if (kind == 5) scol = (nl < 32) ? (32 * nt + nl) : (DFF + 32 * nt + nl - 32);
    else scol = nt * 64 + nl;
    float4 v = make_float4(0.f, 0.f, 0.f, 0.f);
    if (scol < Nsrc) v = *reinterpret_cast<const float4*>(src + (size_t)(kt * 64 + kr) * Nsrc + scol);
    tile[kr * 65 + nl + 0] = v.x; tile[kr * 65 + nl + 1] = v.y; tile[kr * 65 + nl + 2] = v.z; tile[kr * 65 + nl + 3] = v.w;
  }
  __syncthreads();
  int n = tid >> 2, ks = (tid & 3) * 16;
  float v[16];
#pragma unroll
  for (int i = 0; i < 16; ++i) v[i] = tile[(ks + i) * 65 + n];
  u16* dp = dst + (size_t)(nt * 64 + n) * K + kt * 64 + ks;
  *reinterpret_cast<uint4*>(dp) = pack8(v);
  *reinterpret_cast<uint4*>(dp + 8) = pack8(v + 8);
}
constexpr int CV_IN = 16 * 116, CV_PO = 8 * 16, CV_OUT = 16 * 16, CV_FI = 16 * 88, CV_FO = 44 * 16;
constexpr int CV_LORA = 4 * 8 + 16;
constexpr int CV_TOTAL = CV_IN + 3 * CV_PO + CV_OUT + CV_FI + CV_FO + CV_LORA;
__device__ __forceinline__ void convert_item(const Params& P, int layer, int it, char* smem) {
  u16* wb = P.wb[layer & 1];
  if (it < CV_IN) { convert_tile(P.in[I_WIN] + (size_t)layer * 1024 * NIN, NIN, wb + WB_IN, 1024, it % 16, it / 16, 0, smem); return; }
  it -= CV_IN;
  if (it < 3 * CV_PO) {
    int w = it / CV_PO, r = it % CV_PO;
    convert_tile(P.in[I_WPA + w] + (size_t)layer * 512 * 1024, 1024, wb + WB_PO + (size_t)w * 1024 * 512, 512, r % 8, r / 8, 1 + w, smem);
    return;
  }
  it -= 3 * CV_PO;
  if (it < CV_OUT) { convert_tile(P.in[I_WOUT] + (size_t)layer * 1024 * 1024, 1024, wb + WB_OUT, 1024, it % 16, it / 16, 4, smem); return; }
  it -= CV_OUT;
  if (it < CV_FI) { convert_tile(P.in[I_WFI] + (size_t)layer * 1024 * 5632, 5632, wb + WB_FI, 1024, it % 16, it / 16, 5, smem); return; }
  it -= CV_FI;
  if (it < CV_FO) { convert_tile(P.in[I_WFO] + (size_t)layer * DFF * 1024, 1024, wb + WB_FO, DFF, it % 44, it / 44, 6, smem); return; }
  it -= CV_FO;
  if (it < 32) {
    int mtx = it >> 3, nt = it & 7;
    const float* src = P.in[(mtx < 2) ? I_W2 : I_A2] + (size_t)(layer * 2 + (mtx & 1)) * 64 * 512;
    convert_tile(src, 512, wb + WB_LORA + (size_t)mtx * 32768, 64, 0, nt, 7, smem);
    return;
  }
  it -= 32;
  convert_tile(P.in[I_G2] + (size_t)layer * 128 * 512, 512, wb + WB_LORA + (size_t)4 * 32768, 128, it & 1, it >> 1, 8, smem);
}

__device__ __forceinline__ void adaln_item(const Params& P, int it, char* smem) {
  int layer = it / 96, nb = it % 96;
  float* sc = (float*)smem;
  float* red = sc + 3072;
  int tid = ltid();
  __syncthreads();
  for (int e = tid; e < 3072; e += NTHREADS) {
    int c = e >> 10, k = e & 1023;
    float v = (c == 0) ? P.in[I_CCTX][k] : P.in[I_C][(c - 1) * 1024 + k];
    sc[e] = siluf_(v);
  }
  __syncthreads();
  int cg4 = (tid & 15) * 4, ks = tid >> 4;
  float acc[3][4];
#pragma unroll
  for (int c = 0; c < 3; ++c)
#pragma unroll
    for (int j = 0; j < 4; ++j) acc[c][j] = 0.f;
  const float* w = P.in[I_WADA] + (size_t)layer * 1024 * 6144 + nb * 64 + cg4;
#pragma unroll 4
  for (int i = 0; i < 64; ++i) {
    int k = i * 16 + ks;
    float4 wv = *reinterpret_cast<const float4*>(w + (size_t)k * 6144);
#pragma unroll
    for (int c = 0; c < 3; ++c) {
      float s = sc[c * 1024 + k];
      acc[c][0] += s * wv.x; acc[c][1] += s * wv.y; acc[c][2] += s * wv.z; acc[c][3] += s * wv.w;
    }
  }
#pragma unroll
  for (int c = 0; c < 3; ++c)
#pragma unroll
    for (int j = 0; j < 4; ++j) red[(ks * 3 + c) * 64 + cg4 + j] = acc[c][j];
  __syncthreads();
  if (tid < 192) {
    int c = tid >> 6, col = tid & 63;
    float s = P.in[I_BADA][layer * 6144 + nb * 64 + col];
#pragma unroll
    for (int k2 = 0; k2 < 16; ++k2) s += red[(k2 * 3 + c) * 64 + col];
    P.mod[((size_t)layer * 3 + c) * 6144 + nb * 64 + col] = s;
  }
}

__device__ __forceinline__ void cache_item(const Params& P, int it) {
  int e = it * NTHREADS + ltid();
  int d = e & 63, kvh = (e >> 6) & 1, key = (e >> 7) & 255, l = (e >> 15) & 3, b = e >> 17;
  float kv = P.in[I_CK][e], vv = P.in[I_CV][e];
  size_t hb = ((size_t)(l * 2 + b) * 2 + kvh);
  P.klat[(hb * 1280 + key) * 64 + d] = f2bf(kv);
  P.vtlat[(hb * 64 + d) * 1280 + key] = f2bf(vv);
}

__device__ __forceinline__ void norm_item(const Params& P, int layer, int which, int it) {
  int lane = ltid() & 63, wave = ltid() >> 6;
  int m = it * 4 + wave;
  const float* xrow;
  if (which == 0 && layer == 0) xrow = (m < NCTX) ? P.in[I_XP] + (size_t)m * D : P.in[I_XS] + (size_t)(m - NCTX) * D;
  else xrow = P.out + (size_t)m * D;
  const float* g = P.in[which ? I_GFFN : I_GMIX] + layer * D;
  const float* md = P.mod + ((size_t)layer * 3 + cond_of(m)) * 6144 + (which ? 3 * D : 0);
  float4 xv[4];
  float ss = 0.f;
#pragma unroll
  for (int i = 0; i < 4; ++i) {
    xv[i] = *reinterpret_cast<const float4*>(xrow + i * 256 + lane * 4);
    ss += xv[i].x * xv[i].x + xv[i].y * xv[i].y + xv[i].z * xv[i].z + xv[i].w * xv[i].w;
  }
  ss = group_sum<64>(ss);
  float rs = rsqrtf(ss * (1.f / 1024.f) + 1e-6f);
#pragma unroll
  for (int i = 0; i < 4; ++i) {
    int c = i * 256 + lane * 4;
    float4 gv = *reinterpret_cast<const float4*>(g + c);
    float4 sh = *reinterpret_cast<const float4*>(md + c);
    float4 scv = *reinterpret_cast<const float4*>(md + D + c);
    float a0 = xv[i].x * rs * gv.x * (1.f + scv.x) + sh.x;
    float a1 = xv[i].y * rs * gv.y * (1.f + scv.y) + sh.y;
    float a2 = xv[i].z * rs * gv.z * (1.f + scv.z) + sh.z;
    float a3 = xv[i].w * rs * gv.w * (1.f + scv.w) + sh.w;
    uint2 o; o.x = pack2(a0, a1); o.y = pack2(a2, a3);
    *reinterpret_cast<uint2*>(P.h + (size_t)m * D + c) = o;
  }
}

__device__ __forceinline__ void glds16(const u16* g, char* l) {
  __builtin_amdgcn_global_load_lds((const unsigned*)g, (__attribute__((address_space(3))) unsigned*)l, 16, 0, 0);
}
template <int BM, int BN, int WM, int WN>
__device__ __forceinline__ void gemm_core(const u16* __restrict__ A, int lda, const u16* __restrict__ B, int ldb, int K,
                                          int m0, int n0, char* smem, f32x16 (&acc)[BM / (32 * WM)][BN / (32 * WN)]) {
  constexpr int NA = BM / 32;
  constexpr int NB = BN / 32;
  constexpr int MI = BM / (32 * WM), NI = BN / (32 * WN);
  const u16* sA = (const u16*)smem;
  const u16* sB = sA + 2 * 128 * 64;
  const int tid = ltid(), lane = tid & 63, wave = tid >> 6;
  const int wm = wave / WN, wn = wave % WN;
  const int lr = tid >> 3, lc = tid & 7;
  const u16* Ap = A + (size_t)(m0 + lr) * lda + ((lc ^ (lr & 7)) << 3);
  const u16* Bp = B + (size_t)(n0 + lr) * ldb + ((lc ^ (lr & 7)) << 3);
  char* lA = smem + tid * 16;
  char* lB = smem + 32768 + tid * 16;
  const int nk = K >> 6;
  __syncthreads();
#pragma unroll
  for (int i = 0; i < NA; ++i) glds16(Ap + (size_t)i * 32 * lda, lA + i * 4096);
#pragma unroll
  for (int i = 0; i < NB; ++i) glds16(Bp + (size_t)i * 32 * ldb, lB + i * 4096);
  asm volatile("s_waitcnt vmcnt(0)" ::: "memory");
  __syncthreads();
  const int r31 = lane & 31, hh = lane >> 5;
  for (int kt = 0; kt < nk; ++kt) {
    const int cur = kt & 1;
    if (kt + 1 < nk) {
#pragma unroll
      for (int i = 0; i < NA; ++i) glds16(Ap + (size_t)i * 32 * lda + (kt + 1) * 64, lA + (cur ^ 1) * (BM * 128) + i * 4096);
#pragma unroll
      for (int i = 0; i < NB; ++i) glds16(Bp + (size_t)i * 32 * ldb + (kt + 1) * 64, lB + (cur ^ 1) * (BN * 128) + i * 4096);
    }
    const u16* cA = sA + cur * BM * 64;
    const u16* cB = sB + cur * BN * 64;
    bf16x8 af[2][MI], bfr[2][NI];
#pragma unroll
    for (int mi = 0; mi < MI; ++mi) {
      int row = wm * (BM / WM) + mi * 32 + r31;
      af[0][mi] = ld8(cA + row * 64 + ((hh ^ (row & 7)) << 3));
    }
#pragma unroll
    for (int ni = 0; ni < NI; ++ni) {
      int row = wn * (BN / WN) + ni * 32 + r31;
      bfr[0][ni] = ld8(cB + row * 64 + ((hh ^ (row & 7)) << 3));
    }
#pragma unroll
    for (int ks = 0; ks < 4; ++ks) {
      if (ks + 1 < 4) {
#pragma unroll
        for (int mi = 0; mi < MI; ++mi) {
          int row = wm * (BM / WM) + mi * 32 + r31;
          af[(ks + 1) & 1][mi] = ld8(cA + row * 64 + ((((ks + 1) * 2 + hh) ^ (row & 7)) << 3));
        }
#pragma unroll
        for (int ni = 0; ni < NI; ++ni) {
          int row = wn * (BN / WN) + ni * 32 + r31;
          bfr[(ks + 1) & 1][ni] = ld8(cB + row * 64 + ((((ks + 1) * 2 + hh) ^ (row & 7)) << 3));
        }
      }
#pragma unroll
      for (int mi = 0; mi < MI; ++mi)
#pragma unroll
        for (int ni = 0; ni < NI; ++ni) acc[mi][ni] = mfma(af[ks & 1][mi], bfr[ks & 1][ni], acc[mi][ni]);
    }
    asm volatile("s_waitcnt vmcnt(0)" ::: "memory");
    __syncthreads();
  }
}

__device__ __forceinline__ bool tile_coords(int iter, int mt, int nt, int& tm, int& tn) {
  int G = gridDim.x, b = lbid();
  int t;
  if ((G & 7) == 0) {
    int nloc = G >> 3;
    t = ((iter * 8 + (b & 7)) * nloc) + (b >> 3);
  } else {
    t = iter * G + b;
  }
  int total = mt * nt;
  if (t >= total) return false;
  int full = nt >> 3;
  int fullTiles = full * mt * 8;
  if (t < fullTiles) {
    int band = t / (mt * 8), rem = t % (mt * 8);
    int g = rem >> 6, i = rem & 63;
    tm = g * 8 + (i & 7);
    tn = band * 8 + (i >> 3);
  } else {
    int rem = t - fullTiles;
    tm = rem % mt;
    tn = full * 8 + rem / mt;
  }
  return true;
}
__device__ __forceinline__ int tile_iters(int mt, int nt) {
  int G = gridDim.x;
  int total = mt * nt;
  if ((G & 7) == 0) {
    int nloc = G >> 3;
    int chunks = (total + nloc - 1) / nloc;
    return (chunks + 7) / 8;
  }
  return (total + G - 1) / G;
}

__device__ __forceinline__ void gemm_in_phase(const Params& P, int layer, char* smem) {
  const u16* W = P.wb[layer & 1] + WB_IN;
  const int mt = NTOK / 128, nt = LDP / 128;
  const int lane = ltid() & 63, wave = ltid() >> 6, wm = wave >> 1, wn = wave & 1;
  int iters = tile_iters(mt, nt);
  for (int it = 0; it < iters; ++it) {
    int tm, tn;
    if (!tile_coords(it, mt, nt, tm, tn)) continue;
    f32x16 acc[2][2];
#pragma unroll
    for (int a = 0; a < 2; ++a)
#pragma unroll
      for (int b = 0; b < 2; ++b) acc[a][b] = zero16();
    gemm_core<128, 128, 2, 2>(P.h, D, W, D, D, tm * 128, tn * 128, smem, acc);
#pragma unroll
    for (int mi = 0; mi < 2; ++mi)
#pragma unroll
      for (int ni = 0; ni < 2; ++ni)
#pragma unroll
        for (int r = 0; r < 16; ++r) {
          int row = tm * 128 + wm * 64 + mi * 32 + accrow(r, lane >> 5);
          int col = tn * 128 + wn * 64 + ni * 32 + (lane & 31);
          P.p[(size_t)row * LDP + col] = f2bf(acc[mi][ni][r]);
        }
  }
}

__device__ __forceinline__ void gemm_po_phase(const Params& P, int layer, char* smem) {
  const u16* W = P.wb[layer & 1] + WB_PO;
  const int mt = NTOK / 96, nt = D / 128;
  const int lane = ltid() & 63, wave = ltid() >> 6;
  int iters = tile_iters(mt, nt);
  for (int it = 0; it < iters; ++it) {
    int tm, tn;
    if (!tile_coords(it, mt, nt, tm, tn)) continue;
    f32x16 tot[3];
    tot[0] = zero16(); tot[1] = zero16(); tot[2] = zero16();
    const int col = tn * 128 + wave * 32 + (lane & 31);
    for (int br = 0; br < 3; ++br) {
      f32x16 acc[3][1];
      acc[0][0] = zero16(); acc[1][0] = zero16(); acc[2][0] = zero16();
      gemm_core<96, 128, 1, 4>(P.ocat + br * 512, 1536, W + (size_t)br * 1024 * 512, 512, 512, tm * 96, tn * 128, smem, acc);
      const u16* gp = P.p + (size_t)(tm * 96 + 4 * (lane >> 5)) * LDP + OFF_GATE + br * D + col;
#pragma unroll
      for (int mi = 0; mi < 3; ++mi) {
#pragma unroll
        for (int q = 0; q < 4; ++q) {
          const u16* gq = gp + (size_t)(mi * 32 + 8 * q) * LDP;
          float g0 = sigmoidf_(bf2f(gq[0])), g1 = sigmoidf_(bf2f(gq[LDP])), g2 = sigmoidf_(bf2f(gq[2 * LDP])),
                g3 = sigmoidf_(bf2f(gq[3 * LDP]));
          tot[mi][4 * q + 0] += g0 * acc[mi][0][4 * q + 0];
          tot[mi][4 * q + 1] += g1 * acc[mi][0][4 * q + 1];
          tot[mi][4 * q + 2] += g2 * acc[mi][0][4 * q + 2];
          tot[mi][4 * q + 3] += g3 * acc[mi][0][4 * q + 3];
          __builtin_amdgcn_sched_barrier(0);
        }
      }
    }
#pragma unroll
    for (int mi = 0; mi < 3; ++mi)
#pragma unroll
      for (int r = 0; r < 16; ++r) {
        int row = tm * 96 + mi * 32 + accrow(r, lane >> 5);
        P.h[(size_t)row * D + col] = f2bf(tot[mi][r]);
      }
  }
}

__device__ __forceinline__ void gemm_res_phase(const Params& P, int layer, int which, char* smem) {
  const u16* A; const u16* W; int K, lda;
  if (which == 0) { A = P.h; lda = D; W = P.wb[layer & 1] + WB_OUT; K = D; }
  else { A = P.p; lda = DFF; W = P.wb[layer & 1] + WB_FO; K = DFF; }
  const int mt = NTOK / 96, nt = D / 128;
  const int lane = ltid() & 63, wave = ltid() >> 6;
  int iters = tile_iters(mt, nt);
  for (int it = 0; it < iters; ++it) {
    int tm, tn;
    if (!tile_coords(it, mt, nt, tm, tn)) continue;
    f32x16 acc[3][1];
    acc[0][0] = zero16(); acc[1][0] = zero16(); acc[2][0] = zero16();
    gemm_core<96, 128, 1, 4>(A, lda, W, K, K, tm * 96, tn * 128, smem, acc);
    const int col = tn * 128 + wave * 32 + (lane & 31);
#pragma unroll
    for (int mi = 0; mi < 3; ++mi)
#pragma unroll
      for (int r = 0; r < 16; ++r) {
        int row = tm * 96 + mi * 32 + accrow(r, lane >> 5);
        const float* xin;
        if (which == 0 && layer == 0) xin = (row < NCTX) ? P.in[I_XP] + (size_t)row * D : P.in[I_XS] + (size_t)(row - NCTX) * D;
        else xin = P.out + (size_t)row * D;
        float gt = P.mod[((size_t)layer * 3 + cond_of(row)) * 6144 + (which ? 5 * D : 2 * D) + col];
        P.out[(size_t)row * D + col] = xin[col] + gt * acc[mi][0][r];
      }
  }
}

__device__ __forceinline__ void gemm_ffi_phase(const Params& P, int layer, char* smem) {
  const u16* W = P.wb[layer & 1] + WB_FI;
  const int mt = NTOK / 128, nt = 5632 / 128;
  const int lane = ltid() & 63, wave = ltid() >> 6, wm = wave >> 1, wn = wave & 1;
  u16* act = P.p;
  int iters = tile_iters(mt, nt);
  for (int it = 0; it < iters; ++it) {
    int tm, tn;
    if (!tile_coords(it, mt, nt, tm, tn)) continue;
    f32x16 acc[2][2];
#pragma unroll
    for (int a = 0; a < 2; ++a)
#pragma unroll
      for (int b = 0; b < 2; ++b) acc[a][b] = zero16();
    gemm_core<128, 128, 2, 2>(P.h, D, W, D, D, tm * 128, tn * 128, smem, acc);
    int j = tn * 2 + wn;
#pragma unroll
    for (int mi = 0; mi < 2; ++mi)
#pragma unroll
      for (int r = 0; r < 16; ++r) {
        int row = tm * 128 + wm * 64 + mi * 32 + accrow(r, lane >> 5);
        int col = j * 32 + (lane & 31);
        act[(size_t)row * DFF + col] = f2bf(siluf_(acc[mi][0][r]) * acc[mi][1][r]);
      }
  }
}

__device__ __forceinline__ void rope8(float* v, int d0, int t) {
  float row = (float)(t >> 6), col = (float)(t & 63);
#pragma unroll
  for (int i = 0; i < 4; ++i) {
    int pi = (d0 >> 1) + i;
    float pos = (pi < 16) ? row : col;
    float inv = exp2f(-(float)(pi & 15) * (13.287712379549449f / 16.f));
    float ang = pos * inv;
    float n = rintf(ang * 0.15915494309189535f);
    float rr = fmaf(-n, 6.2831855f, ang);
    rr = fmaf(-n, -1.7484555e-7f, rr);
    float sn = __sinf(rr), cs = __cosf(rr);
    float x0 = v[2 * i], x1 = v[2 * i + 1];
    v[2 * i] = x0 * cs - x1 * sn;
    v[2 * i + 1] = x0 * sn + x1 * cs;
  }
}

__device__ __forceinline__ void attn_prep_item(const Params& P, int layer, int it) {
  int lane = ltid() & 63, wave = ltid() >> 6;
  int m = it * 4 + wave;
  const u16* prow = P.p + (size_t)m * LDP;
  bool lat = m >= NCTX;
  int b, t;
  if (!lat) { b = m >> 8; t = m & 255; } else { b = (m - NCTX) >> 10; t = (m - NCTX) & 1023; }
  {
    float v[8];
    unpack8(*reinterpret_cast<const uint4*>(prow + lane * 8), v);
    float ss = 0.f;
#pragma unroll
    for (int i = 0; i < 8; ++i) ss += v[i] * v[i];
    ss = group_sum<8>(ss);
    float rs = rsqrtf(ss * (1.f / 64.f) + 1e-6f);
    int d0 = (lane & 7) * 8;
#pragma unroll
    for (int i = 0; i < 8; ++i) v[i] = v[i] * rs * P.in[I_QG][layer * 64 + d0 + i];
    if (lat) rope8(v, d0, t);
    *reinterpret_cast<uint4*>(P.qbuf + (size_t)m * 512 + lane * 8) = pack8(v);
  }
  {
    int l2 = lane & 31;
    float v[8];
    unpack8(*reinterpret_cast<const uint4*>(prow + OFF_KA + l2 * 8), v);
    float ss = 0.f;
#pragma unroll
    for (int i = 0; i < 8; ++i) ss += v[i] * v[i];
    ss = group_sum<8>(ss);
    int d0 = (l2 & 7) * 8;
    int kvh = (l2 >> 3) & 1;
    if (l2 < 16) {
      float rs = rsqrtf(ss * (1.f / 64.f) + 1e-6f);
#pragma unroll
      for (int i = 0; i < 8; ++i) v[i] = v[i] * rs * P.in[I_KG][layer * 64 + d0 + i];
      if (!lat) {
        if (lane < 32) {
          float* ok = P.out + O_CK + (((size_t)(b * 4 + layer) * 256 + t) * 2 + kvh) * 64 + d0;
          *reinterpret_cast<float4*>(ok) = make_float4(v[0], v[1], v[2], v[3]);
          *reinterpret_cast<float4*>(ok + 4) = make_float4(v[4], v[5], v[6], v[7]);
          *reinterpret_cast<uint4*>(P.kctx + (((size_t)(b * 2 + kvh)) * 256 + t) * 64 + d0) = pack8(v);
        }
      } else {
        rope8(v, d0, t);
        if (lane < 32)
          *reinterpret_cast<uint4*>(P.klat + ((((size_t)(layer * 2 + b)) * 2 + kvh) * 1280 + 256 + t) * 64 + d0) = pack8(v);
      }
    } else {
      if (lane < 32) {
        if (!lat) {
          float* ov = P.out + O_CV + (((size_t)(b * 4 + layer) * 256 + t) * 2 + kvh) * 64 + d0;
          *reinterpret_cast<float4*>(ov) = make_float4(v[0], v[1], v[2], v[3]);
          *reinterpret_cast<float4*>(ov + 4) = make_float4(v[4], v[5], v[6], v[7]);
          u16* vt = P.vtctx + ((size_t)(b * 2 + kvh) * 64 + d0) * 256 + t;
#pragma unroll
          for (int i = 0; i < 8; ++i) vt[i * 256] = f2bf(v[i]);
        } else {
          u16* vt = P.vtlat + ((((size_t)(layer * 2 + b)) * 2 + kvh) * 64 + d0) * 1280 + 256 + t;
#pragma unroll
          for (int i = 0; i < 8; ++i) vt[i * 1280] = f2bf(v[i]);
        }
      }
    }
  }
}

__device__ __forceinline__ void gla_prep_item(const Params& P, int layer, int it, char* smem) {
  int chunk = it >> 2, h = it & 3;
  int m0 = chunk * 64;
  int tid = ltid();
  float* bc = (float*)smem;
  u16* sq = (u16*)(smem + 32768);
  u16* sk = sq + 4096;
  u16* slr = sk + 4096;
  __syncthreads();
  {
    int row = tid >> 2, seg = (tid & 3) * 16;
    const u16* pr = P.p + (size_t)(m0 + row) * LDP;
    *reinterpret_cast<uint4*>(sq + row * 64 + seg) = *reinterpret_cast<const uint4*>(pr + OFF_QB + h * 64 + seg);
    *reinterpret_cast<uint4*>(sq + row * 64 + seg + 8) = *reinterpret_cast<const uint4*>(pr + OFF_QB + h * 64 + seg + 8);
    *reinterpret_cast<uint4*>(sk + row * 64 + seg) = *reinterpret_cast<const uint4*>(pr + OFF_KB + h * 64 + seg);
    *reinterpret_cast<uint4*>(sk + row * 64 + seg + 8) = *reinterpret_cast<const uint4*>(pr + OFF_KB + h * 64 + seg + 8);
    int part = tid & 3;
    *reinterpret_cast<uint4*>(slr + ((part >> 1) * 64 + row) * 16 + (part & 1) * 8) =
        *reinterpret_cast<const uint4*>(pr + OFF_GKF + part * 8);
  }
  __syncthreads();
  {
    int dk = tid & 63, tg = tid >> 6;
#pragma unroll
    for (int dir = 0; dir < 2; ++dir) {
      float w[16];
#pragma unroll
      for (int r = 0; r < 16; ++r) w[r] = P.in[I_GKW2][((size_t)(layer * 2 + dir) * 16 + r) * 256 + h * 64 + dk];
      float bias = P.in[I_GKB][(layer * 2 + dir) * 256 + h * 64 + dk];
      for (int tt = 0; tt < 16; ++tt) {
        int t = tg * 16 + tt;
        float z = bias;
#pragma unroll
        for (int r = 0; r < 16; ++r) z += bf2f(slr[(dir * 64 + t) * 16 + r]) * w[r];
        float ls = fminf(z, 0.f) - __logf(1.f + __expf(-fabsf(z)));
        bc[(dir * 64 + t) * 64 + dk] = ls * (1.f / 16.f);
      }
    }
  }
  __syncthreads();
  if (tid < 128) {
    int dk = tid & 63, dir = tid >> 6;
    float run = 0.f;
    if (dir == 0) { for (int t = 0; t < 64; ++t) { run += bc[t * 64 + dk]; bc[t * 64 + dk] = run; } }
    else { for (int t = 63; t >= 0; --t) { run += bc[(64 + t) * 64 + dk]; bc[(64 + t) * 64 + dk] = run; } }
  }
  __syncthreads();
  {
    int t = tid >> 2, seg = (tid & 3) * 16;
#pragma unroll
    for (int dir = 0; dir < 2; ++dir) {
      float qv[16], kv[16];
#pragma unroll
      for (int i = 0; i < 16; ++i) {
        float bb = bc[(dir * 64 + t) * 64 + seg + i];
        qv[i] = bf2f(sq[t * 64 + seg + i]) * 0.125f * __expf(bb);
        kv[i] = bf2f(sk[t * 64 + seg + i]) * __expf(-bb);
      }
      size_t o = ((size_t)dir * NTOK + m0 + t) * 256 + h * 64 + seg;
      *reinterpret_cast<uint4*>(P.gqe + o) = pack8(qv);
      *reinterpret_cast<uint4*>(P.gqe + o + 8) = pack8(qv + 8);
      *reinterpret_cast<uint4*>(P.gke + o) = pack8(kv);
      *reinterpret_cast<uint4*>(P.gke + o + 8) = pack8(kv + 8);
    }
  }
  {
    int dk = tid >> 2, iseg = (tid & 3) * 16;
#pragma unroll
    for (int dir = 0; dir < 2; ++dir) {
      float blast = bc[(dir * 64 + (dir ? 0 : 63)) * 64 + dk];
      float kv[16];
#pragma unroll
      for (int ii = 0; ii < 16; ++ii) {
        int i = iseg + ii;
        int t = dir ? 63 - i : i;
        kv[ii] = bf2f(sk[t * 64 + dk]) * __expf(blast - bc[(dir * 64 + t) * 64 + dk]);
      }
      size_t o = ((((size_t)dir * 96 + chunk) * 4 + h) * 64 + dk) * 64 + iseg;
      *reinterpret_cast<uint4*>(P.gklT + o) = pack8(kv);
      *reinterpret_cast<uint4*>(P.gklT + o + 8) = pack8(kv + 8);
      if ((tid & 3) == 0) P.gdl[((size_t)dir * 96 + chunk) * 256 + h * 64 + dk] = __expf(blast);
    }
  }
  {
    int dv = tid >> 1, iseg = (tid & 1) * 32;
#pragma unroll
    for (int dir = 0; dir < 2; ++dir) {
      size_t o = ((((size_t)dir * 96 + chunk) * 4 + h) * 128 + dv) * 64 + iseg;
#pragma unroll
      for (int g = 0; g < 4; ++g) {
        unsigned w[4];
#pragma unroll
        for (int q = 0; q < 4; ++q) {
          int i0 = iseg + g * 8 + q * 2;
          int t0 = dir ? 63 - i0 : i0, t1 = dir ? 63 - (i0 + 1) : i0 + 1;
          unsigned a = P.p[(size_t)(m0 + t0) * LDP + OFF_VB + h * 128 + dv];
          unsigned b2 = P.p[(size_t)(m0 + t1) * LDP + OFF_VB + h * 128 + dv];
          w[q] = a | (b2 << 16);
        }
        *reinterpret_cast<uint4*>(P.gvT + o + g * 8) = make_uint4(w[0], w[1], w[2], w[3]);
      }
    }
  }
  asm volatile("s_waitcnt vmcnt(0)" ::: "memory");
  __syncthreads();
  {
    const int lane = tid & 63, wave = tid >> 6;
    const int r31 = lane & 31, hh = lane >> 5;
    const int dv = wave * 32 + r31;
#pragma unroll 1
    for (int dir = 0; dir < 2; ++dir) {
      const u16* qeb = P.gqe + (size_t)dir * NTOK * 256 + h * 64;
      const u16* keb = P.gke + (size_t)dir * NTOK * 256 + h * 64;
      u16* ob = P.ob + (size_t)dir * NTOK * 512 + h * 128 + dv;
      const int tokA0 = m0 + (dir ? 63 - r31 : r31);
      const int tokA1 = m0 + (dir ? 31 - r31 : 32 + r31);
      const u16* vT = P.gvT + ((((size_t)dir * 96 + chunk) * 4 + h) * 128 + dv) * 64;
      const u16* klT = P.gklT + ((((size_t)dir * 96 + chunk) * 4 + h) * 64) * 64;
      f32x16 X00 = zero16(), X01 = zero16(), X11 = zero16();
#pragma unroll
      for (int ks = 0; ks < 4; ++ks) {
        bf16x8 k0 = ld8(keb + (size_t)tokA0 * 256 + ks * 16 + hh * 8);
        bf16x8 k1 = ld8(keb + (size_t)tokA1 * 256 + ks * 16 + hh * 8);
        bf16x8 q0 = ld8(qeb + (size_t)tokA0 * 256 + ks * 16 + hh * 8);
        bf16x8 q1 = ld8(qeb + (size_t)tokA1 * 256 + ks * 16 + hh * 8);
        X00 = mfma(k0, q0, X00);
        X01 = mfma(k0, q1, X01);
        X11 = mfma(k1, q1, X11);
      }
#pragma unroll
      for (int r = 0; r < 16; ++r) {
        bool keep = accrow(r, hh) <= r31;
        X00[r] = keep ? X00[r] : 0.f;
        X11[r] = keep ? X11[r] : 0.f;
      }
#pragma unroll 1
      for (int tt = 0; tt < 2; ++tt) {
        f32x16 O = zero16();
#pragma unroll
        for (int sx = 0; sx < 2; ++sx) {
          const u16* vp = vT + 16 * sx + 4 * hh;
          bf16x8 v0 = ld4x2(vp, vp + 8);
          if (tt == 0) {
            O = mfma(acc2frag(X00, sx), v0, O);
          } else {
            bf16x8 v1 = ld4x2(vp + 32, vp + 40);
            O = mfma(acc2frag(X01, sx), v0, O);
            O = mfma(acc2frag(X11, sx), v1, O);
          }
        }
#pragma unroll
        for (int r = 0; r < 16; ++r) {
          int i = tt * 32 + accrow(r, hh);
          int tok = m0 + (dir ? 63 - i : i);
          ob[(size_t)tok * 512] = f2bf(O[r]);
        }
      }
      float* gu = P.gU + ((((size_t)dir * 96 + chunk) * 4 + h) * 128 + dv) * 64 + 4 * hh;
#pragma unroll
      for (int d2 = 0; d2 < 2; ++d2) {
        f32x16 U = zero16();
#pragma unroll
        for (int ks = 0; ks < 4; ++ks) {
          bf16x8 a = ld8(klT + (size_t)(d2 * 32 + r31) * 64 + ks * 16 + hh * 8);
          bf16x8 b2 = ld8(vT + ks * 16 + hh * 8);
          U = mfma(a, b2, U);
        }
#pragma unroll
        for (int g = 0; g < 4; ++g)
          *reinterpret_cast<float4*>(gu + d2 * 32 + 8 * g) = make_float4(U[4 * g], U[4 * g + 1], U[4 * g + 2], U[4 * g + 3]);
      }
    }
  }
}

__device__ __forceinline__ float tanhf_(float x) { return 1.f - 2.f * __builtin_amdgcn_rcpf(__expf(2.f * x) + 1.f); }
__device__ __forceinline__ float pick4(const float4& v, int j) { return j == 0 ? v.x : (j == 1 ? v.y : (j == 2 ? v.z : v.w)); }
__device__ __forceinline__ void rwkv_prep_item(const Params& P, int layer, int it, char* smem) {
  const int tt = it >> 2, hp = it & 3;
  const int m0 = tt * 32;
  int sbase, T;
  { int s = m0 < NCTX ? (m0 >> 8) : 16 + ((m0 - NCTX) >> 10); seq_info(s, sbase, T); }
  const int tid = ltid(), lane = tid & 63, wave = tid >> 6;
  constexpr int LS = 392;
  u16* lin = (u16*)smem;
  const float* mu = P.in[I_MU] + layer * 1920;
  __syncthreads();
#pragma unroll 1
  for (int half = 0; half < 1; ++half) {
    uint4 lu[6], lp[6], ln[6];
    const uint4 z4 = make_uint4(0u, 0u, 0u, 0u);
#pragma unroll
    for (int q = 0; q < 6; ++q) {
      int g = tid + (half * 6 + q) * NTHREADS;
      int tk = g / 48, cg8 = g % 48;
      int m = m0 + tk, t = m - sbase;
      const u16* pr = P.p + (size_t)m * LDP + OFF_C + 1536 + cg8 * 8;
      lu[q] = *reinterpret_cast<const uint4*>(pr);
      lp[q] = (t > 0) ? *reinterpret_cast<const uint4*>(pr - LDP) : z4;
      ln[q] = (t < T - 1) ? *reinterpret_cast<const uint4*>(pr + LDP) : z4;
    }
#pragma unroll
    for (int q = 0; q < 6; ++q) {
      int g = tid + (half * 6 + q) * NTHREADS;
      int tk = g / 48, cg8 = g % 48;
      float u[8], pv[8], nx[8], o[8];
      unpack8(lu[q], u); unpack8(lp[q], pv); unpack8(ln[q], nx);
      float4 mu0 = *reinterpret_cast<const float4*>(mu + 1536 + cg8 * 8);
      float4 mu1 = *reinterpret_cast<const float4*>(mu + 1536 + cg8 * 8 + 4);
      float mus[8] = {mu0.x, mu0.y, mu0.z, mu0.w, mu1.x, mu1.y, mu1.z, mu1.w};
      const float sa_ = (cg8 < 16) ? 2.f : 1.f, sc_ = (cg8 < 16) ? -1.f : 0.f;
      const bool ident = (cg8 >= 16) && (cg8 < 32);
#pragma unroll
      for (int i = 0; i < 8; ++i) {
        float pc = u[i] + mus[i] * (0.5f * (pv[i] + nx[i]) - u[i]);
        float sg = __builtin_amdgcn_rcpf(1.f + __expf(-sa_ * pc));
        o[i] = ident ? pc : (sa_ * sg + sc_);
      }
      *reinterpret_cast<uint4*>(lin + tk * LS + cg8 * 8) = pack8(o);
    }
  }
  __syncthreads();
  const int hsub = wave >> 1, chh = wave & 1;
  const int hq = hp * 2 + hsub;
  const int r31 = lane & 31, hh = lane >> 5;
  f32x16 acc[5];
#pragma unroll
  for (int q = 0; q < 5; ++q) acc[q] = zero16();
  {
    const u16* wl = P.wb[layer & 1] + WB_LORA;
    const int cw = hq * 64 + chh * 32 + r31;
    const u16* lrow = lin + r31 * LS + hh * 8;
#pragma unroll
    for (int q = 0; q < 4; ++q)
#pragma unroll
      for (int ks = 0; ks < 4; ++ks)
        acc[q] = mfma(ld8(wl + (size_t)q * 32768 + cw * 64 + ks * 16 + hh * 8), ld8(lrow + q * 64 + ks * 16), acc[q]);
#pragma unroll
    for (int ks = 0; ks < 8; ++ks)
      acc[4] = mfma(ld8(wl + (size_t)4 * 32768 + cw * 128 + ks * 16 + hh * 8), ld8(lrow + 256 + ks * 16), acc[4]);
  }
  __syncthreads();
  u16* raw = (u16*)smem + hsub * 6528;
  float* red = (float*)(smem + 32768) + hsub * 128;
  {
    uint4 sv[7];
#pragma unroll
    for (int q = 0; q < 7; ++q) {
      int g = tid + q * NTHREADS;
      int hs = g / 816, g2 = g % 816;
      int part = (g2 >> 3) % 3, rr = g2 / 24, chunk = g2 & 7;
      int m = m0 - 1 + rr, t = m - sbase;
      sv[q] = make_uint4(0u, 0u, 0u, 0u);
      if (g < 2 * 34 * 24 && t >= 0 && t < T)
        sv[q] = *reinterpret_cast<const uint4*>(P.p + (size_t)m * LDP + OFF_C + part * 512 + (hp * 2 + hs) * 64 + chunk * 8);
    }
#pragma unroll
    for (int q = 0; q < 7; ++q) {
      int g = tid + q * NTHREADS;
      int hs = g / 816, g2 = g % 816;
      int part = (g2 >> 3) % 3, rr = g2 / 24, chunk = g2 & 7;
      if (g < 2 * 34 * 24) *reinterpret_cast<uint4*>((u16*)smem + hs * 6528 + (rr * 3 + part) * 64 + chunk * 8) = sv[q];
    }
  }
  __syncthreads();
  const int tl = r31;
  const int m = m0 + tl;
  float kkf[16], aF[16], aB[16];
  float ssq = 0.f, bon = 0.f;
#pragma unroll
  for (int g4 = 0; g4 < 4; ++g4) {
    const int cl0 = chh * 32 + 8 * g4 + 4 * hh;
    const int c0 = hq * 64 + cl0;
    const float4 w0f = *reinterpret_cast<const float4*>(P.in[I_W0] + (layer * 2 + 0) * 512 + c0);
    const float4 w0b = *reinterpret_cast<const float4*>(P.in[I_W0] + (layer * 2 + 1) * 512 + c0);
    const float4 a0f = *reinterpret_cast<const float4*>(P.in[I_A0] + (layer * 2 + 0) * 512 + c0);
    const float4 a0b = *reinterpret_cast<const float4*>(P.in[I_A0] + (layer * 2 + 1) * 512 + c0);
    const float4 kkc = *reinterpret_cast<const float4*>(P.in[I_KK] + layer * 512 + c0);
    const float4 kac = *reinterpret_cast<const float4*>(P.in[I_KA] + layer * 512 + c0);
    const float4 rkc = *reinterpret_cast<const float4*>(P.in[I_RK] + layer * 512 + c0);
    const float4 mur = *reinterpret_cast<const float4*>(mu + c0);
    const float4 muk = *reinterpret_cast<const float4*>(mu + 512 + c0);
    const float4 muv = *reinterpret_cast<const float4*>(mu + 1024 + c0);
    float sh[3][4];
#pragma unroll
    for (int part = 0; part < 3; ++part) {
      uint2 pu = *reinterpret_cast<const uint2*>(raw + ((tl + 0) * 3 + part) * 64 + cl0);
      uint2 cu = *reinterpret_cast<const uint2*>(raw + ((tl + 1) * 3 + part) * 64 + cl0);
      uint2 nu = *reinterpret_cast<const uint2*>(raw + ((tl + 2) * 3 + part) * 64 + cl0);
      unsigned pw[2] = {pu.x, pu.y}, cw2[2] = {cu.x, cu.y}, nw[2] = {nu.x, nu.y};
#pragma unroll
      for (int j = 0; j < 4; ++j) {
        float uu = bf2f((u16)(cw2[j >> 1] >> (16 * (j & 1))));
        float pp = bf2f((u16)(pw[j >> 1] >> (16 * (j & 1))));
        float nn = bf2f((u16)(nw[j >> 1] >> (16 * (j & 1))));
        float muj = pick4(part == 0 ? mur : (part == 1 ? muk : muv), j);
        sh[part][j] = uu + muj * (0.5f * (pp + nn) - uu);
      }
    }
    float o_dec[2][4], o_kd[2][4], o_gc[4];
#pragma unroll
    for (int j = 0; j < 4; ++j) {
      const int r = 4 * g4 + j;
      float rv = sh[0][j], kv = sh[1][j];
      float af = sigmoidf_(pick4(a0f, j) + acc[2][r]);
      float ab = sigmoidf_(pick4(a0b, j) + acc[3][r]);
      float wlf = pick4(w0f, j) + acc[0][r];
      float wlb = pick4(w0b, j) + acc[1][r];
      o_dec[0][j] = __expf(-0.6065306597126334f * sigmoidf_(wlf));
      o_dec[1][j] = __expf(-0.6065306597126334f * sigmoidf_(wlb));
      float ka = pick4(kac, j);
      o_kd[0][j] = kv * (1.f + (af - 1.f) * ka);
      o_kd[1][j] = kv * (1.f + (ab - 1.f) * ka);
      o_gc[j] = acc[4][r];
      float kf = kv * pick4(kkc, j);
      kkf[r] = kf; aF[r] = af; aB[r] = ab;
      ssq += kf * kf;
      bon += rv * pick4(rkc, j) * (o_kd[0][j] + o_kd[1][j]);
    }
    size_t o = (size_t)m * 512 + c0;
    *reinterpret_cast<uint2*>(P.rr + o) = pack4(sh[0][0], sh[0][1], sh[0][2], sh[0][3]);
    *reinterpret_cast<uint2*>(P.rv + o) = pack4(sh[2][0], sh[2][1], sh[2][2], sh[2][3]);
    *reinterpret_cast<uint2*>(P.rgc + o) = pack4(o_gc[0], o_gc[1], o_gc[2], o_gc[3]);
#pragma unroll
    for (int d = 0; d < 2; ++d) {
      size_t od = (size_t)d * NTOK * 512 + o;
      *reinterpret_cast<float4*>(P.rdec + od) = make_float4(o_dec[d][0], o_dec[d][1], o_dec[d][2], o_dec[d][3]);
      *reinterpret_cast<uint2*>(P.rkd + od) = pack4(o_kd[d][0], o_kd[d][1], o_kd[d][2], o_kd[d][3]);
    }
  }
  ssq += __shfl_xor(ssq, 32, 64);
  bon += __shfl_xor(bon, 32, 64);
  if (hh == 0) { red[tl * 2 + chh] = ssq; red[(32 + tl) * 2 + chh] = bon; }
  __syncthreads();
  const float ssq_t = red[tl * 2] + red[tl * 2 + 1];
  const float bon_t = red[(32 + tl) * 2] + red[(32 + tl) * 2 + 1];
  const float rn = rsqrtf(ssq_t + 1e-12f);
#pragma unroll
  for (int g4 = 0; g4 < 4; ++g4) {
    const int c0 = hq * 64 + chh * 32 + 8 * g4 + 4 * hh;
    size_t o = (size_t)m * 512 + c0;
    float kk[4];
#pragma unroll
    for (int j = 0; j < 4; ++j) kk[j] = kkf[4 * g4 + j] * rn;
    *reinterpret_cast<uint2*>(P.rnkk + o) = pack4(-kk[0], -kk[1], -kk[2], -kk[3]);
    *reinterpret_cast<uint2*>(P.rbk + o) =
        pack4(kk[0] * aF[4 * g4], kk[1] * aF[4 * g4 + 1], kk[2] * aF[4 * g4 + 2], kk[3] * aF[4 * g4 + 3]);
    *reinterpret_cast<uint2*>(P.rbk + (size_t)NTOK * 512 + o) =
        pack4(kk[0] * aB[4 * g4], kk[1] * aB[4 * g4 + 1], kk[2] * aB[4 * g4 + 2], kk[3] * aB[4 * g4 + 3]);
  }
  if (chh == 0 && hh == 0) P.rbon[(size_t)m * 8 + hq] = bon_t;
}

__device__ __forceinline__ void attn_item(const Params& P, int layer, int it) {
  int lane = ltid() & 63, wave = ltid() >> 6;
  int nkeys, qtok, head;
  const u16 *kb, *vt;
  if (it < 128) {
    int b = it >> 6, qb = it & 7; head = (it >> 3) & 7;
    int kvh = head >> 2;
    nkeys = 1280;
    qtok = NCTX + b * 1024 + qb * 128;
    size_t hb = ((size_t)(layer * 2 + b) * 2 + kvh);
    kb = P.klat + hb * 1280 * 64;
    vt = P.vtlat + hb * 64 * 1280;
  } else {
    int j = it - 128;
    int b = j >> 4, qb = j & 1; head = (j >> 1) & 7;
    int kvh = head >> 2;
    nkeys = 256;
    qtok = b * 256 + qb * 128;
    kb = P.kctx + (size_t)(b * 2 + kvh) * 256 * 64;
    vt = P.vtctx + (size_t)(b * 2 + kvh) * 64 * 256;
  }
  int q0 = qtok + wave * 32;
  int r31 = lane & 31, hh = lane >> 5;
  bf16x8 qf[4];
  {
    const u16* qp = P.qbuf + (size_t)(q0 + r31) * 512 + head * 64 + hh * 8;
#pragma unroll
    for (int ks = 0; ks < 4; ++ks) qf[ks] = ld8(qp + ks * 16);
  }
  f32x16 o[2];
  o[0] = zero16(); o[1] = zero16();
  float mrun = -1e30f, lrun = 0.f;
  for (int kt = 0; kt < nkeys; kt += 64) {
    f32x16 x[2];
#pragma unroll
    for (int sub = 0; sub < 2; ++sub) {
      x[sub] = zero16();
      const u16* kp = kb + (size_t)(kt + sub * 32 + r31) * 64 + hh * 8;
#pragma unroll
      for (int ks = 0; ks < 4; ++ks) x[sub] = mfma(ld8(kp + ks * 16), qf[ks], x[sub]);
    }
    float mx = -1e30f;
#pragma unroll
    for (int sub = 0; sub < 2; ++sub)
#pragma unroll
      for (int r = 0; r < 16; ++r) mx = fmaxf(mx, x[sub][r]);
    mx = fmaxf(mx, __shfl_xor(mx, 32, 64));
    float mnew = fmaxf(mrun, mx * 0.125f);
    float alpha = __expf(mrun - mnew);
    mrun = mnew;
    float psum = 0.f;
    bf16x8 pf[2][2];
#pragma unroll
    for (int sub = 0; sub < 2; ++sub)
#pragma unroll
      for (int r = 0; r < 16; ++r) {
        float pv = __expf(x[sub][r] * 0.125f - mnew);
        psum += pv;
        pf[sub][r >> 3][r & 7] = (short)f2bf(pv);
      }
    lrun = lrun * alpha + psum;
#pragma unroll
    for (int dt = 0; dt < 2; ++dt) {
#pragma unroll
      for (int r = 0; r < 16; ++r) o[dt][r] *= alpha;
      const u16* vp = vt + (size_t)(dt * 32 + r31) * nkeys + kt + 4 * hh;
#pragma unroll
      for (int sub = 0; sub < 2; ++sub)
#pragma unroll
        for (int s = 0; s < 2; ++s) {
          bf16x8 vf = ld4x2(vp + sub * 32 + 16 * s, vp + sub * 32 + 16 * s + 8);
          o[dt] = mfma(vf, pf[sub][s], o[dt]);
        }
    }
  }
  lrun += __shfl_xor(lrun, 32, 64);
  float inv = __builtin_amdgcn_rcpf(lrun);
  u16* op = P.ocat + (size_t)(q0 + r31) * 1536 + head * 64;
#pragma unroll
  for (int dt = 0; dt < 2; ++dt)
#pragma unroll
    for (int g = 0; g < 4; ++g) {
      int d = dt * 32 + 8 * g + 4 * hh;
      uint2 w;
      w.x = pack2(o[dt][4 * g + 0] * inv, o[dt][4 * g + 1] * inv);
      w.y = pack2(o[dt][4 * g + 2] * inv, o[dt][4 * g + 3] * inv);
      *reinterpret_cast<uint2*>(op + d) = w;
    }
}

__device__ __forceinline__ void gla_scan_item(const Params& P, int layer, int it) {
  int lane = ltid() & 63, wave = ltid() >> 6;
  int s, h, dir;
  if (it < 16) { s = 16 + (it >> 3); h = (it >> 1) & 3; dir = it & 1; }
  else { int j = it - 16; s = j >> 3; h = (j >> 1) & 3; dir = j & 1; }
  int sbase, T;
  seq_info(s, sbase, T);
  const int nch = T >> 6;
  const int r31 = lane & 31, hh = lane >> 5;
  const int dv = wave * 32 + r31;
  f32x16 S[2];
  if (s >= 16) {
    const float* sp = P.in[I_SG] + ((((size_t)(s - 16) * 4 + layer) * 2 + dir) * 4 + h) * 64 * 128;
#pragma unroll
    for (int d2 = 0; d2 < 2; ++d2)
#pragma unroll
      for (int r = 0; r < 16; ++r) S[d2][r] = sp[(size_t)(d2 * 32 + accrow(r, hh)) * 128 + dv];
  } else { S[0] = zero16(); S[1] = zero16(); }
  const u16* qeb = P.gqe + (size_t)dir * NTOK * 256 + h * 64;
  u16* obi = P.obi + (size_t)dir * NTOK * 512 + h * 128 + dv;
  bf16x8 qf[2][2][2];
  auto load_q = [&](int cs, bf16x8 (&q)[2][2][2]) {
    int ctok = dir ? nch - 1 - cs : cs;
    int m0 = sbase + ctok * 64;
#pragma unroll
    for (int tt = 0; tt < 2; ++tt) {
      int i = tt * 32 + r31;
      int tok = m0 + (dir ? 63 - i : i);
#pragma unroll
      for (int d2 = 0; d2 < 2; ++d2)
#pragma unroll
        for (int sx = 0; sx < 2; ++sx) {
          const u16* qp = qeb + (size_t)tok * 256 + d2 * 32 + 16 * sx + 4 * hh;
          q[tt][d2][sx] = ld4x2(qp, qp + 8);
        }
    }
  };
#pragma unroll 1
  for (int cs = 0; cs < nch; ++cs) {
    load_q(cs, qf);
    const int ctok = dir ? nch - 1 - cs : cs;
    const int m0 = sbase + ctok * 64;
    const int gchunk = m0 >> 6;
    const float* gu = P.gU + ((((size_t)dir * 96 + gchunk) * 4 + h) * 128 + dv) * 64 + 4 * hh;
    const float* dl = P.gdl + ((size_t)dir * 96 + gchunk) * 256 + h * 64 + 4 * hh;
    float4 U[2][4];
    float4 dlv[2][4];
#pragma unroll
    for (int d2 = 0; d2 < 2; ++d2)
#pragma unroll
      for (int g = 0; g < 4; ++g) {
        U[d2][g] = *reinterpret_cast<const float4*>(gu + d2 * 32 + 8 * g);
        dlv[d2][g] = *reinterpret_cast<const float4*>(dl + d2 * 32 + 8 * g);
      }
#pragma unroll
    for (int tt = 0; tt < 2; ++tt) {
      f32x16 O = zero16();
#pragma unroll
      for (int d2 = 0; d2 < 2; ++d2)
#pragma unroll
        for (int sx = 0; sx < 2; ++sx) O = mfma(qf[tt][d2][sx], acc2frag(S[d2], sx), O);
      {
        const int i0 = tt * 32 + 4 * hh;
        u16* po = obi + (size_t)(m0 + (dir ? 63 - i0 : i0)) * 512;
        const long step = dir ? -512 : 512;
#pragma unroll
        for (int g = 0; g < 4; ++g) {
          po[(8 * g + 0) * step] = f2bf(O[4 * g + 0]);
          po[(8 * g + 1) * step] = f2bf(O[4 * g + 1]);
          po[(8 * g + 2) * step] = f2bf(O[4 * g + 2]);
          po[(8 * g + 3) * step] = f2bf(O[4 * g + 3]);
          __builtin_amdgcn_sched_barrier(0);
        }
      }
    }
#pragma unroll
    for (int d2 = 0; d2 < 2; ++d2)
#pragma unroll
      for (int g = 0; g < 4; ++g) {
        S[d2][4 * g + 0] = S[d2][4 * g + 0] * dlv[d2][g].x + U[d2][g].x;
        S[d2][4 * g + 1] = S[d2][4 * g + 1] * dlv[d2][g].y + U[d2][g].y;
        S[d2][4 * g + 2] = S[d2][4 * g + 2] * dlv[d2][g].z + U[d2][g].z;
        S[d2][4 * g + 3] = S[d2][4 * g + 3] * dlv[d2][g].w + U[d2][g].w;
      }
  }
  if (s < 16) {
    float* sp = P.out + O_SG + ((((size_t)s * 4 + layer) * 2 + dir) * 4 + h) * 64 * 128;
#pragma unroll
    for (int d2 = 0; d2 < 2; ++d2)
#pragma unroll
      for (int r = 0; r < 16; ++r) sp[(size_t)(d2 * 32 + accrow(r, hh)) * 128 + dv] = S[d2][r];
  }
}

template <int CTRL, int RS>
__device__ __forceinline__ void dpp_stage(float (&x)[RS]) {
#pragma unroll
  for (int i = 0; i < RS; ++i) x[i] = dpp_addf<CTRL>(x[i]);
}
template <int RS>
__device__ __forceinline__ void rwkv_scan_item(const Params& P, int layer, int s, int h, int dir, int rb, char* smem) {
  constexpr int NR = 16 * RS;
  int tid = ltid(), lane = tid & 63, wave = tid >> 6;
  int sbase, T;
  seq_info(s, sbase, T);
  if (s >= 16) __builtin_amdgcn_s_setprio(3);
  const int lrow = wave * 4 + (lane >> 4);
  const int c0 = (lane & 15) * 4;
  float4 S[RS];
#pragma unroll
  for (int rs = 0; rs < RS; ++rs) {
    S[rs] = make_float4(0.f, 0.f, 0.f, 0.f);
    if (s >= 16)
      S[rs] = *reinterpret_cast<const float4*>(P.in[I_SR] + (((((size_t)(s - 16) * 4 + layer) * 2 + dir) * 8 + h) * 64 + rb * NR + rs * 16 + lrow) * 64 + c0);
  }
  constexpr int BUF = 5 * 1024 + 2 * 16 * NR;
  float* buf = (float*)smem;
  const int lst = tid >> 4, lc4 = (tid & 15) * 4;
  const u16* gR = P.rr + h * 64;
  const float* gW = P.rdec + (size_t)dir * NTOK * 512 + h * 64;
  const u16* gK = P.rkd + (size_t)dir * NTOK * 512 + h * 64;
  const u16* gA = P.rnkk + h * 64;
  const u16* gB = P.rbk + (size_t)dir * NTOK * 512 + h * 64;
  const u16* gV = P.rv + h * 64 + rb * NR;
  float* yo = P.ry + (size_t)dir * NTOK * 512 + h * 64 + rb * NR;
  float4 pr, pw, pk, pa, pb; float pv[RS];
  __syncthreads();
  {
    int tok = sbase + (dir ? T - 1 - lst : lst);
    size_t o = (size_t)tok * 512;
    pr = unpack4(*reinterpret_cast<const uint2*>(gR + o + lc4));
    pw = *reinterpret_cast<const float4*>(gW + o + lc4);
    pk = unpack4(*reinterpret_cast<const uint2*>(gK + o + lc4));
    pa = unpack4(*reinterpret_cast<const uint2*>(gA + o + lc4));
    pb = unpack4(*reinterpret_cast<const uint2*>(gB + o + lc4));
#pragma unroll
    for (int q = 0; q < RS; ++q) {
      int idx = tid + q * NTHREADS, st = idx / NR, rr = idx % NR;
      int tk = sbase + (dir ? T - 1 - st : st);
      pv[q] = bf2f(gV[(size_t)tk * 512 + rr]);
    }
    float* bw = buf;
    *reinterpret_cast<float4*>(bw + 0 * 1024 + lst * 64 + lc4) = pr;
    *reinterpret_cast<float4*>(bw + 1 * 1024 + lst * 64 + lc4) = pw;
    *reinterpret_cast<float4*>(bw + 2 * 1024 + lst * 64 + lc4) = pk;
    *reinterpret_cast<float4*>(bw + 3 * 1024 + lst * 64 + lc4) = pa;
    *reinterpret_cast<float4*>(bw + 4 * 1024 + lst * 64 + lc4) = pb;
#pragma unroll
    for (int q = 0; q < RS; ++q) bw[5 * 1024 + tid + q * NTHREADS] = pv[q];
  }
  __syncthreads();
  const int nch = T >> 4;
#pragma unroll 1
  for (int ch = 0; ch < nch; ++ch) {
    const int cur = ch & 1;
    if (ch + 1 < nch) {
      int si = (ch + 1) * 16 + lst;
      int tok = sbase + (dir ? T - 1 - si : si);
      size_t o = (size_t)tok * 512;
      pr = unpack4(*reinterpret_cast<const uint2*>(gR + o + lc4));
      pw = *reinterpret_cast<const float4*>(gW + o + lc4);
      pk = unpack4(*reinterpret_cast<const uint2*>(gK + o + lc4));
      pa = unpack4(*reinterpret_cast<const uint2*>(gA + o + lc4));
      pb = unpack4(*reinterpret_cast<const uint2*>(gB + o + lc4));
#pragma unroll
      for (int q = 0; q < RS; ++q) {
        int idx = tid + q * NTHREADS, st = idx / NR, rr = idx % NR;
        int s2 = (ch + 1) * 16 + st;
        int tk = sbase + (dir ? T - 1 - s2 : s2);
        pv[q] = bf2f(gV[(size_t)tk * 512 + rr]);
      }
    }
    float* bb = buf + cur * BUF;
    float4 r4 = *reinterpret_cast<const float4*>(bb + 0 * 1024 + c0);
    float4 w4 = *reinterpret_cast<const float4*>(bb + 1 * 1024 + c0);
    float4 k4 = *reinterpret_cast<const float4*>(bb + 2 * 1024 + c0);
    float4 a4 = *reinterpret_cast<const float4*>(bb + 3 * 1024 + c0);
    float4 b4 = *reinterpret_cast<const float4*>(bb + 4 * 1024 + c0);
    float vv[RS];
#pragma unroll
    for (int rs = 0; rs < RS; ++rs) vv[rs] = bb[5 * 1024 + rs * 16 + lrow];
#pragma unroll
    for (int st = 0; st < 16; ++st) {
      float4 nr4, nw4, nk4, na4, nb4; float nvv[RS];
      if (st + 1 < 16) {
        nr4 = *reinterpret_cast<const float4*>(bb + 0 * 1024 + (st + 1) * 64 + c0);
        nw4 = *reinterpret_cast<const float4*>(bb + 1 * 1024 + (st + 1) * 64 + c0);
        nk4 = *reinterpret_cast<const float4*>(bb + 2 * 1024 + (st + 1) * 64 + c0);
        na4 = *reinterpret_cast<const float4*>(bb + 3 * 1024 + (st + 1) * 64 + c0);
        nb4 = *reinterpret_cast<const float4*>(bb + 4 * 1024 + (st + 1) * 64 + c0);
#pragma unroll
        for (int rs = 0; rs < RS; ++rs) nvv[rs] = bb[5 * 1024 + (st + 1) * NR + rs * 16 + lrow];
      }
      float sa[RS], y[RS];
#pragma unroll
      for (int rs = 0; rs < RS; ++rs) sa[rs] = (S[rs].x * a4.x + S[rs].y * a4.y) + (S[rs].z * a4.z + S[rs].w * a4.w);
      dpp_stage<0xB1, RS>(sa); dpp_stage<0x4E, RS>(sa); dpp_stage<0x141, RS>(sa); dpp_stage<0x140, RS>(sa);
#pragma unroll
      for (int rs = 0; rs < RS; ++rs) {
        S[rs].x = S[rs].x * w4.x + (sa[rs] * b4.x + vv[rs] * k4.x);
        S[rs].y = S[rs].y * w4.y + (sa[rs] * b4.y + vv[rs] * k4.y);
        S[rs].z = S[rs].z * w4.z + (sa[rs] * b4.z + vv[rs] * k4.z);
        S[rs].w = S[rs].w * w4.w + (sa[rs] * b4.w + vv[rs] * k4.w);
        y[rs] = (S[rs].x * r4.x + S[rs].y * r4.y) + (S[rs].z * r4.z + S[rs].w * r4.w);
      }
      dpp_stage<0xB1, RS>(y); dpp_stage<0x4E, RS>(y); dpp_stage<0x141, RS>(y); dpp_stage<0x140, RS>(y);
      if ((lane & 15) == 0) {
#pragma unroll
        for (int rs = 0; rs < RS; ++rs) bb[5 * 1024 + 16 * NR + st * NR + rs * 16 + lrow] = y[rs];
      }
      if (st + 1 < 16) {
        r4 = nr4; w4 = nw4; k4 = nk4; a4 = na4; b4 = nb4;
#pragma unroll
        for (int rs = 0; rs < RS; ++rs) vv[rs] = nvv[rs];
      }
    }
    if (ch + 1 < nch) {
      float* bw = buf + (cur ^ 1) * BUF;
      *reinterpret_cast<float4*>(bw + 0 * 1024 + lst * 64 + lc4) = pr;
      *reinterpret_cast<float4*>(bw + 1 * 1024 + lst * 64 + lc4) = pw;
      *reinterpret_cast<float4*>(bw + 2 * 1024 + lst * 64 + lc4) = pk;
      *reinterpret_cast<float4*>(bw + 3 * 1024 + lst * 64 + lc4) = pa;
      *reinterpret_cast<float4*>(bw + 4 * 1024 + lst * 64 + lc4) = pb;
#pragma unroll
      for (int q = 0; q < RS; ++q) bw[5 * 1024 + tid + q * NTHREADS] = pv[q];
    }
    __syncthreads();
#pragma unroll
    for (int q = 0; q < RS; ++q) {
      int idx = tid + q * NTHREADS, st = idx / NR, rr = idx % NR;
      int si = ch * 16 + st;
      int tok = sbase + (dir ? T - 1 - si : si);
      yo[(size_t)tok * 512 + rr] = bb[5 * 1024 + 16 * NR + idx];
    }
  }
  if (s < 16) {
#pragma unroll
    for (int rs = 0; rs < RS; ++rs)
      *reinterpret_cast<float4*>(P.out + O_SR + (((((size_t)s * 4 + layer) * 2 + dir) * 8 + h) * 64 + rb * NR + rs * 16 + lrow) * 64 + c0) = S[rs];
  }
  if (s >= 16) __builtin_amdgcn_s_setprio(0);
}

typedef float f2_t __attribute__((ext_vector_type(2)));
__device__ __forceinline__ void rwkv_scan_lat(const Params& P, int layer, int it, char* smem) {
  const int tid = ltid(), lane = tid & 63, wave = tid >> 6;
  const int s = 16 + (it >> 6), h = (it >> 3) & 7, dir = (it >> 2) & 1, rb = it & 3;
  int sbase, T;
  seq_info(s, sbase, T);
  __builtin_amdgcn_s_setprio(3);
  const int lrow = wave * 4 + (lane >> 4);
  const int row = rb * 16 + lrow;
  const int l15 = lane & 15;
  const int c0 = l15 * 4;
  f2_t S01, S23;
  {
    float4 s4 = *reinterpret_cast<const float4*>(P.in[I_SR] + (((((size_t)(s - 16) * 4 + layer) * 2 + dir) * 8 + h) * 64 + row) * 64 + c0);
    S01 = (f2_t){s4.x, s4.y}; S23 = (f2_t){s4.z, s4.w};
  }
  constexpr int BUF = 5 * 1024 + 256;
  float* buf = (float*)smem;
  float* ypart = buf + 2 * BUF;
  const int lst = tid >> 4, lc4 = (tid & 15) * 4, lrr = tid & 15;
  const u16* gR = P.rr + h * 64;
  const float* gW = P.rdec + (size_t)dir * NTOK * 512 + h * 64;
  const u16* gK = P.rkd + (size_t)dir * NTOK * 512 + h * 64;
  const u16* gA = P.rnkk + h * 64;
  const u16* gB = P.rbk + (size_t)dir * NTOK * 512 + h * 64;
  const u16* gV = P.rv + h * 64 + rb * 16;
  float* yo = P.ry + (size_t)dir * NTOK * 512 + h * 64 + rb * 16;
  float4 pr, pw, pk, pa, pb; float pv;
  __syncthreads();
  {
    int tok = sbase + (dir ? T - 1 - lst : lst);
    size_t o = (size_t)tok * 512;
    pr = unpack4(*reinterpret_cast<const uint2*>(gR + o + lc4));
    pw = *reinterpret_cast<const float4*>(gW + o + lc4);
    pk = unpack4(*reinterpret_cast<const uint2*>(gK + o + lc4));
    pa = unpack4(*reinterpret_cast<const uint2*>(gA + o + lc4));
    pb = unpack4(*reinterpret_cast<const uint2*>(gB + o + lc4));
    pv = bf2f(gV[o + lrr]);
    float* bw = buf;
    *reinterpret_cast<float4*>(bw + 0 * 1024 + lst * 64 + lc4) = pr;
    *reinterpret_cast<float4*>(bw + 1 * 1024 + lst * 64 + lc4) = pw;
    *reinterpret_cast<float4*>(bw + 2 * 1024 + lst * 64 + lc4) = pk;
    *reinterpret_cast<float4*>(bw + 3 * 1024 + lst * 64 + lc4) = pa;
    *reinterpret_cast<float4*>(bw + 4 * 1024 + lst * 64 + lc4) = pb;
    bw[5 * 1024 + tid] = pv;
  }
  __syncthreads();
  const int nch = T >> 4;
#pragma unroll 1
  for (int ch = 0; ch < nch; ++ch) {
    const int cur = ch & 1;
    if (ch + 1 < nch) {
      int si = (ch + 1) * 16 + lst;
      int tok = sbase + (dir ? T - 1 - si : si);
      size_t o = (size_t)tok * 512;
      pr = unpack4(*reinterpret_cast<const uint2*>(gR + o + lc4));
      pw = *reinterpret_cast<const float4*>(gW + o + lc4);
      pk = unpack4(*reinterpret_cast<const uint2*>(gK + o + lc4));
      pa = unpack4(*reinterpret_cast<const uint2*>(gA + o + lc4));
      pb = unpack4(*reinterpret_cast<const uint2*>(gB + o + lc4));
      pv = bf2f(gV[o + lrr]);
    }
    const float* bb = buf + cur * BUF;
    float4 Rr[4], Rw[4], Rk[4], Ra[4], Rb[4]; float Rv[4];
#pragma unroll
    for (int q = 0; q < 3; ++q) {
      Rr[q] = *reinterpret_cast<const float4*>(bb + 0 * 1024 + q * 64 + c0);
      Rw[q] = *reinterpret_cast<const float4*>(bb + 1 * 1024 + q * 64 + c0);
      Rk[q] = *reinterpret_cast<const float4*>(bb + 2 * 1024 + q * 64 + c0);
      Ra[q] = *reinterpret_cast<const float4*>(bb + 3 * 1024 + q * 64 + c0);
      Rb[q] = *reinterpret_cast<const float4*>(bb + 4 * 1024 + q * 64 + c0);
      Rv[q] = bb[5 * 1024 + q * 16 + lrow];
    }
#pragma unroll
    for (int st = 0; st < 16; ++st) {
      if (st + 3 < 16) {
        const int q = (st + 3) & 3;
        Rr[q] = *reinterpret_cast<const float4*>(bb + 0 * 1024 + (st + 3) * 64 + c0);
        Rw[q] = *reinterpret_cast<const float4*>(bb + 1 * 1024 + (st + 3) * 64 + c0);
        Rk[q] = *reinterpret_cast<const float4*>(bb + 2 * 1024 + (st + 3) * 64 + c0);
        Ra[q] = *reinterpret_cast<const float4*>(bb + 3 * 1024 + (st + 3) * 64 + c0);
        Rb[q] = *reinterpret_cast<const float4*>(bb + 4 * 1024 + (st + 3) * 64 + c0);
        Rv[q] = bb[5 * 1024 + (st + 3) * 16 + lrow];
      }
      const float4 r4 = Rr[st & 3], w4 = Rw[st & 3], k4 = Rk[st & 3], a4 = Ra[st & 3], b4 = Rb[st & 3];
      const float vv = Rv[st & 3];
      const f2_t a01 = {a4.x, a4.y}, a23 = {a4.z, a4.w}, b01 = {b4.x, b4.y}, b23 = {b4.z, b4.w};
      const f2_t k01 = {k4.x, k4.y}, k23 = {k4.z, k4.w}, w01 = {w4.x, w4.y}, w23 = {w4.z, w4.w};
      const f2_t r01 = {r4.x, r4.y}, r23 = {r4.z, r4.w};
      f2_t t = S01 * a01;
      t = __builtin_elementwise_fma(S23, a23, t);
      float sa = t.x + t.y;
      sa = dpp_addf<0xB1>(sa); sa = dpp_addf<0x4E>(sa); sa = dpp_addf<0x141>(sa); sa = dpp_addf<0x140>(sa);
      const f2_t sa2 = {sa, sa}, vv2 = {vv, vv};
      f2_t u01 = sa2 * b01, u23 = sa2 * b23;
      u01 = __builtin_elementwise_fma(vv2, k01, u01);
      u23 = __builtin_elementwise_fma(vv2, k23, u23);
      S01 = __builtin_elementwise_fma(S01, w01, u01);
      S23 = __builtin_elementwise_fma(S23, w23, u23);
      f2_t y2 = S01 * r01;
      y2 = __builtin_elementwise_fma(S23, r23, y2);
      ypart[(st * 16 + lrow) * 16 + l15] = y2.x + y2.y;
    }
    if (ch + 1 < nch) {
      float* bw = buf + (cur ^ 1) * BUF;
      *reinterpret_cast<float4*>(bw + 0 * 1024 + lst * 64 + lc4) = pr;
      *reinterpret_cast<float4*>(bw + 1 * 1024 + lst * 64 + lc4) = pw;
      *reinterpret_cast<float4*>(bw + 2 * 1024 + lst * 64 + lc4) = pk;
      *reinterpret_cast<float4*>(bw + 3 * 1024 + lst * 64 + lc4) = pa;
      *reinterpret_cast<float4*>(bw + 4 * 1024 + lst * 64 + lc4) = pb;
      bw[5 * 1024 + tid] = pv;
    }
    __syncthreads();
    {
      const float4* yp = reinterpret_cast<const float4*>(ypart + tid * 16);
      float4 q0 = yp[0], q1 = yp[1], q2 = yp[2], q3 = yp[3];
      float ys = ((q0.x + q0.y) + (q0.z + q0.w)) + ((q1.x + q1.y) + (q1.z + q1.w)) +
                 (((q2.x + q2.y) + (q2.z + q2.w)) + ((q3.x + q3.y) + (q3.z + q3.w)));
      int si = ch * 16 + lst;
      int tok = sbase + (dir ? T - 1 - si : si);
      yo[(size_t)tok * 512 + lrr] = ys;
    }
    __syncthreads();
  }
  __builtin_amdgcn_s_setprio(0);
}

__device__ __forceinline__ void post_item(const Params& P, int layer, int it) {
  int lane = ltid() & 63, wave = ltid() >> 6;
  int m = it * 4 + wave;
  {
    float va[8], vb[8], vc8[8], vd[8], v[8];
    unpack8(*reinterpret_cast<const uint4*>(P.ob + (size_t)m * 512 + lane * 8), va);
    unpack8(*reinterpret_cast<const uint4*>(P.ob + (size_t)(NTOK + m) * 512 + lane * 8), vb);
    unpack8(*reinterpret_cast<const uint4*>(P.obi + (size_t)m * 512 + lane * 8), vc8);
    unpack8(*reinterpret_cast<const uint4*>(P.obi + (size_t)(NTOK + m) * 512 + lane * 8), vd);
#pragma unroll
    for (int i = 0; i < 8; ++i) v[i] = (va[i] + vc8[i]) + (vb[i] + vd[i]);
    float ss = 0.f;
#pragma unroll
    for (int i = 0; i < 8; ++i) ss += v[i] * v[i];
    ss = group_sum<16>(ss);
    float rs = rsqrtf(ss * (1.f / 128.f) + 1e-6f);
    float gb[8];
    unpack8(*reinterpret_cast<const uint4*>(P.p + (size_t)m * LDP + OFF_GB + lane * 8), gb);
#pragma unroll
    for (int i = 0; i < 8; ++i) v[i] = v[i] * rs * P.in[I_GLAG][layer * 128 + (lane & 15) * 8 + i] * siluf_(gb[i]);
    *reinterpret_cast<uint4*>(P.ocat + (size_t)m * 1536 + 512 + lane * 8) = pack8(v);
  }
  {
    const float* a = P.ry + (size_t)m * 512 + lane * 8;
    const float* b = a + (size_t)NTOK * 512;
    float v[8];
    float4 a0 = *reinterpret_cast<const float4*>(a), a1 = *reinterpret_cast<const float4*>(a + 4);
    float4 b0 = *reinterpret_cast<const float4*>(b), b1 = *reinterpret_cast<const float4*>(b + 4);
    v[0] = a0.x + b0.x; v[1] = a0.y + b0.y; v[2] = a0.z + b0.z; v[3] = a0.w + b0.w;
    v[4] = a1.x + b1.x; v[5] = a1.y + b1.y; v[6] = a1.z + b1.z; v[7] = a1.w + b1.w;
    float sm = 0.f;
#pragma unroll
    for (int i = 0; i < 8; ++i) sm += v[i];
    sm = group_sum<8>(sm);
    float mean = sm * (1.f / 64.f);
    float vs = 0.f;
#pragma unroll
    for (int i = 0; i < 8; ++i) { float dd = v[i] - mean; vs += dd * dd; }
    vs = group_sum<8>(vs);
    float rs = rsqrtf(vs * (1.f / 64.f) + 64e-5f);
    float bon = P.rbon[(size_t)m * 8 + (lane >> 3)];
    int c = lane * 8;
    float vc[8], gc[8];
    unpack8(*reinterpret_cast<const uint4*>(P.rv + (size_t)m * 512 + c), vc);
    unpack8(*reinterpret_cast<const uint4*>(P.rgc + (size_t)m * 512 + c), gc);
#pragma unroll
    for (int i = 0; i < 8; ++i) {
      float gn = (v[i] - mean) * rs * P.in[I_LNW][layer * 512 + c + i] + P.in[I_LNB][layer * 512 + c + i];
      v[i] = (gn + bon * vc[i]) * gc[i];
    }
    *reinterpret_cast<uint4*>(P.ocat + (size_t)m * 1536 + 1024 + c) = pack8(v);
  }
}

#define XB_TMO      128
#define XB_XCNT(j)  (256  + 64 * (j))
#define XB_XSUB(j)  (1280 + 64 * (j))
#define XB_XGEN(j)  (2304 + 64 * (j))
#define XB_TOP      3328
#define XB_TOPGEN   3392
#define XCD_BAR_WORDS 3456
#define XB_SPIN_CAP (1u << 22)
__device__ __forceinline__ unsigned xb_ld(unsigned* p) { return __hip_atomic_load(p, __ATOMIC_RELAXED, __HIP_MEMORY_SCOPE_AGENT); }
__device__ __forceinline__ unsigned xb_add(unsigned* p, unsigned v) { return __hip_atomic_fetch_add(p, v, __ATOMIC_RELAXED, __HIP_MEMORY_SCOPE_AGENT); }
__device__ __forceinline__ unsigned xb_xcc_id() { return (unsigned)__builtin_amdgcn_s_getreg((3 << 11) | 20) & 0xFu; }
#define XB_SPIN(cond, bar) do { unsigned _sp = 0; while (cond) { __builtin_amdgcn_s_sleep(1); \
    if ((++_sp & 255u) == 0u) { if (xb_ld(&(bar)[XB_TMO])) break; if (_sp > XB_SPIN_CAP) { atomicAdd(&(bar)[XB_TMO], 1u); break; } } } } while (0)
struct XcdBarrier { unsigned* bar; unsigned x; unsigned nloc; unsigned nx; };
__device__ __forceinline__ XcdBarrier xcd_barrier_post(unsigned* bar) {
  XcdBarrier b; b.bar = bar; b.x = xb_xcc_id(); b.nloc = 0u; b.nx = 0u;
  if (threadIdx.x == 0) (void)xb_add(&bar[XB_XCNT(b.x)], 1u);
  return b;
}
__device__ __forceinline__ void xcd_barrier_complete(unsigned* bar, unsigned x, unsigned& nloc, unsigned& nx) {
  const unsigned G = gridDim.x;
  unsigned sum, cnt, mine, sp = 0u;
  for (;;) {
    sum = 0u; cnt = 0u; mine = 0u;
#pragma unroll
    for (unsigned j = 0; j < 16; ++j) { const unsigned c = xb_ld(&bar[XB_XCNT(j)]); sum += c; cnt += (c > 0u) ? 1u : 0u; mine = (j == x) ? c : mine; }
    if (sum == G) break;
    __builtin_amdgcn_s_sleep(1);
    if ((++sp & 255u) == 0u) { if (xb_ld(&bar[XB_TMO])) break; if (sp > XB_SPIN_CAP) { atomicAdd(&bar[XB_TMO], 1u); break; } }
  }
  nloc = mine > 0u ? mine : 1u; nx = cnt > 0u ? cnt : 1u;
}
__device__ __forceinline__ void xcd_barrier(XcdBarrier& b) {
  asm volatile("s_waitcnt vmcnt(0)" ::: "memory");
  __syncthreads();
  if (threadIdx.x == 0) {
    unsigned* bar = b.bar;
    __builtin_amdgcn_s_waitcnt(0);
    if (b.nloc == 0u) xcd_barrier_complete(bar, b.x, b.nloc, b.nx);
    const unsigned nloc = b.nloc, nx = b.nx;
    const unsigned old = xb_add(&bar[XB_XSUB(b.x)], 1u);
    const unsigned gen = old / nloc;
    if (old + 1u == (gen + 1u) * nloc) {
      __builtin_amdgcn_fence(__ATOMIC_RELEASE, "agent");
      asm volatile("s_waitcnt vmcnt(0)" ::: "memory");
      const unsigned og = xb_add(&bar[XB_TOP], 1u);
      const unsigned tg = og / nx;
      if (og + 1u == (tg + 1u) * nx) xb_add(&bar[XB_TOPGEN], 1u);
      else XB_SPIN(xb_ld(&bar[XB_TOPGEN]) == tg, bar);
      __builtin_amdgcn_fence(__ATOMIC_ACQUIRE, "agent");
      xb_add(&bar[XB_XGEN(b.x)], 1u);
      asm volatile("s_waitcnt vmcnt(0)" ::: "memory");
    } else {
      XB_SPIN(xb_ld(&bar[XB_XGEN(b.x)]) == gen, bar);
      __builtin_amdgcn_fence(__ATOMIC_ACQUIRE, "agent");
      asm volatile("s_waitcnt vmcnt(0)" ::: "memory");
    }
  }
  __syncthreads();
}

constexpr int N_PHASES = 1 + 10 * DEPTH;

__device__ __forceinline__ void run_phase(const Params& P, int layer, int sub, char* smem, int rep = 0) {
  const int G = gridDim.x, b = lbid();
  if (sub < 0) {
    const int total = 384 + CV_TOTAL + 1024;
    for (int it = b; it < total; it += G) {
      if (it < 384) adaln_item(P, it, smem);
      else if (it < 384 + CV_TOTAL) convert_item(P, 0, it - 384, smem);
      else cache_item(P, it - 384 - CV_TOTAL);
    }
    return;
  }
  switch (sub) {
    case 0: for (int it = b; it < NTOK / 4; it += G) norm_item(P, layer, 0, it); break;
    case 1: gemm_in_phase(P, layer, smem); break;
    case 2: {
      const int n1 = 768, n2 = 384, n3 = NTOK / 16;
      unsigned* ctr = P.bar + XCD_BAR_WORDS + rep * 512 + 256 + layer * 64;
      volatile int* sitem = (volatile int*)(smem + 65528);
      for (;;) {
        __syncthreads();
        if (threadIdx.x == 0) *sitem = (int)atomicAdd(ctr, 1u);
        __syncthreads();
        const int it = *sitem;
        if (it >= n1 + n2 + n3) break;
        if (it < n2) gla_prep_item(P, layer, it, smem);
        else if (it < n1 + n2) rwkv_prep_item(P, layer, it - n2, smem);
        else { for (int q = 0; q < 4; ++q) attn_prep_item(P, layer, (it - n1 - n2) * 4 + q); }
      }
    } break;
    case 3: {
      const int ncv = (layer + 1 < DEPTH) ? (CV_TOTAL + 1) / 2 : 0;
      const int total = 912 + ncv;
      unsigned* ctr = P.bar + XCD_BAR_WORDS + rep * 512 + layer * 64;
      volatile int* sitem = (volatile int*)(smem + 65528);
      for (;;) {
        __syncthreads();
        if (threadIdx.x == 0) *sitem = (int)atomicAdd(ctr, 1u);
        __syncthreads();
        const int it = *sitem;
        if (it >= total) break;
        if (it < 128) rwkv_scan_lat(P, layer, it, smem);
        else if (it < 144) { for (int q = 0; q < 1 + (PROBE_D == 2); ++q) gla_scan_item(P, layer, it - 128); }
        else if (it < 272) { for (int q = 0; q < 1 + (PROBE_D == 3); ++q) attn_item(P, layer, it - 144); }
        else if (it < 528) { int j = it - 272; rwkv_scan_item<4>(P, layer, j >> 4, (j >> 1) & 7, j & 1, 0, smem); }
        else if (it < 656) gla_scan_item(P, layer, it - 528 + 16);
        else if (it < 912) attn_item(P, layer, it - 656 + 128);
        else {
          const int c0 = (it - 912) * 2;
          for (int q = 0; q < 2; ++q)
            if (c0 + q < CV_TOTAL) convert_item(P, layer + 1, c0 + q, smem);
        }
      }
    } break;
    case 4:
      for (int it = b; it < NTOK / 8; it += G) { post_item(P, layer, 2 * it); post_item(P, layer, 2 * it + 1); }
      break;
    case 5: gemm_po_phase(P, layer, smem); break;
    case 6: gemm_res_phase(P, layer, 0, smem); break;
    case 7: for (int it = b; it < NTOK / 4; it += G) norm_item(P, layer, 1, it); break;
    case 8: gemm_ffi_phase(P, layer, smem); break;
    case 9: gemm_res_phase(P, layer, 1, smem); break;
  }
}

#if !MEGA
template <int SUB>
__global__ void __launch_bounds__(NTHREADS, 2) phase_kernel(Params P, int layer) {
  __shared__ __attribute__((aligned(16))) char smem[65536];
  run_phase(P, layer, SUB, smem);
}
#else
__global__ void __launch_bounds__(NTHREADS, 2) mega_kernel(Params P) {
  __shared__ __attribute__((aligned(16))) char smem[65536];
  cg::grid_group grid = cg::this_grid();
  if (P.out == nullptr) grid.sync();
  XcdBarrier xb = xcd_barrier_post(P.bar);
  for (int ph = 0; ph < N_PHASES; ++ph) {
    int layer = (ph == 0) ? 0 : (ph - 1) / 10;
    int sub = (ph == 0) ? -1 : (ph - 1) % 10;
    run_phase(P, layer, sub, smem);
    if (PROBE_DUP && sub >= 0 && ((PROBE_DUP >> sub) & 1)) { xcd_barrier(xb); run_phase(P, layer, sub, smem, 1); }
    if (ph + 1 < N_PHASES) { for (int q = 0; q < PROBE_SYNCN; ++q) xcd_barrier(xb); }
  }
}
#endif

extern "C" void kernel_launch(void* const* d_in, const int* in_sizes, int n_in, void* d_out, int out_size, void* d_ws,
                              size_t ws_size, hipStream_t stream) {
  Params P{};
  for (int i = 0; i < N_INPUTS; ++i) P.in[i] = (const float*)d_in[i];
  P.out = (float*)d_out;
  char* w = (char*)d_ws;
  size_t off = 0;
  auto alloc = [&](size_t bytes) { char* r = w + off; off += (bytes + 255) & ~(size_t)255; return r; };
  P.wb[0] = (u16*)alloc(WB_TOTAL * 2);
  P.wb[1] = (u16*)alloc(WB_TOTAL * 2);
  P.mod = (float*)alloc((size_t)4 * 3 * 6144 * 4);
  P.h = (u16*)alloc((size_t)NTOK * D * 2);
  P.p = (u16*)alloc((size_t)NTOK * LDP * 2);
  P.qbuf = (u16*)alloc((size_t)NTOK * 512 * 2);
  P.kctx = (u16*)alloc((size_t)16 * 2 * 256 * 64 * 2);
  P.vtctx = (u16*)alloc((size_t)16 * 2 * 64 * 256 * 2);
  P.klat = (u16*)alloc((size_t)4 * 2 * 2 * 1280 * 64 * 2);
  P.vtlat = (u16*)alloc((size_t)4 * 2 * 2 * 64 * 1280 * 2);
  P.gqe = (u16*)alloc((size_t)2 * NTOK * 256 * 2);
  P.gke = (u16*)alloc((size_t)2 * NTOK * 256 * 2);
  P.gklT = (u16*)alloc((size_t)2 * 96 * 4 * 64 * 64 * 2);
  P.gvT = (u16*)alloc((size_t)2 * 96 * 4 * 128 * 64 * 2);
  P.gdl = (float*)alloc((size_t)2 * 96 * 256 * 4);
  P.ob = (u16*)alloc((size_t)2 * NTOK * 512 * 2);
  P.obi = (u16*)alloc((size_t)2 * NTOK * 512 * 2);
  P.gU = (float*)alloc((size_t)2 * 96 * 4 * 64 * 128 * 4);
  P.rr = (u16*)alloc((size_t)NTOK * 512 * 2);
  P.rv = (u16*)alloc((size_t)NTOK * 512 * 2);
  P.rnkk = (u16*)alloc((size_t)NTOK * 512 * 2);
  P.rdec = (float*)alloc((size_t)2 * NTOK * 512 * 4);
  P.rkd = (u16*)alloc((size_t)2 * NTOK * 512 * 2);
  P.rbk = (u16*)alloc((size_t)2 * NTOK * 512 * 2);
  P.rgc = (u16*)alloc((size_t)NTOK * 512 * 2);
  P.rbon = (float*)alloc((size_t)NTOK * 8 * 4);
  P.ry = (float*)alloc((size_t)2 * NTOK * 512 * 4);
  P.ocat = (u16*)alloc((size_t)NTOK * 1536 * 2);
  P.bar = (unsigned*)alloc((size_t)(XCD_BAR_WORDS + 1024) * 4);
  if (off > ws_size) { fprintf(stderr, "workspace too small: need %zu have %zu\n", off, ws_size); return; }

  static int grid_blocks = 0;
  if (!grid_blocks) {
    int dev = 0, cus = 0, per_cu = 0;
    hipGetDevice(&dev);
    hipDeviceGetAttribute(&cus, hipDeviceAttributeMultiprocessorCount, dev);
#if MEGA
    hipOccupancyMaxActiveBlocksPerMultiprocessor(&per_cu, mega_kernel, NTHREADS, 0);
#else
    hipOccupancyMaxActiveBlocksPerMultiprocessor(&per_cu, phase_kernel<1>, NTHREADS, 0);
#endif
    if (per_cu < 1) per_cu = 1;
    if (per_cu > 2) per_cu = 2;
    grid_blocks = cus * per_cu;
  }
#if MEGA
  hipMemsetAsync(P.bar, 0, (size_t)(XCD_BAR_WORDS + 1024) * 4, stream);
  void* args[] = {&P};
  hipError_t e = hipLaunchCooperativeKernel((void*)mega_kernel, dim3(grid_blocks), dim3(NTHREADS), args, 0, stream);
  if (e != hipSuccess) fprintf(stderr, "cooperative launch failed: %s (grid %d)\n", hipGetErrorString(e), grid_blocks);
#else
  phase_kernel<-1><<<grid_blocks, NTHREADS, 0, stream>>>(P, 0);
  for (int l = 0; l < DEPTH; ++l) {
    for (int q = 0; q < 1 + ((PROBE_DUP >> 0) & 1); ++q) phase_kernel<0><<<grid_blocks, NTHREADS, 0, stream>>>(P, l);
    for (int q = 0; q < 1 + ((PROBE_DUP >> 1) & 1); ++q) phase_kernel<1><<<grid_blocks, NTHREADS, 0, stream>>>(P, l);
    for (int q = 0; q < 1 + ((PROBE_DUP >> 2) & 1); ++q) phase_kernel<2><<<grid_blocks, NTHREADS, 0, stream>>>(P, l);
    for (int q = 0; q < 1 + ((PROBE_DUP >> 3) & 1); ++q) phase_kernel<3><<<grid_blocks, NTHREADS, 0, stream>>>(P, l);
    for (int q = 0; q < 1 + ((PROBE_DUP >> 4) & 1); ++q) phase_kernel<4><<<grid_blocks, NTHREADS, 0, stream>>>(P, l);
    for (int q = 0; q < 1 + ((PROBE_DUP >> 5) & 1); ++q) phase_kernel<5><<<grid_blocks, NTHREADS, 0, stream>>>(P, l);
    for (int q = 0; q < 1 + ((PROBE_DUP >> 6) & 1); ++q) phase_kernel<6><<<grid_blocks, NTHREADS, 0, stream>>>(P, l);
    for (int q = 0; q < 1 + ((PROBE_DUP >> 7) & 1); ++q) phase_kernel<7><<<grid_blocks, NTHREADS, 0, stream>>>(P, l);
    for (int q = 0; q < 1 + ((PROBE_DUP >> 8) & 1); ++q) phase_kernel<8><<<grid_blocks, NTHREADS, 0, stream>>>(P, l);
    for (int q = 0; q < 1 + ((PROBE_DUP >> 9) & 1); ++q) phase_kernel<9><<<grid_blocks, NTHREADS, 0, stream>>>(P, l);
  }
#endif
}
```

```cpp
#include <hip/hip_runtime.h>
#include <hip/hip_cooperative_groups.h>
#include <stdint.h>
#include <cstdio>
namespace cg = cooperative_groups;

#ifndef PROBE_SYNCN
#define PROBE_SYNCN 1
#endif
#ifndef PROBE_C
#define PROBE_C 0
#endif
#ifndef PROBE_D
#define PROBE_D 0
#endif
#ifndef PROBE_DUP
#define PROBE_DUP 0
#endif
#ifndef MEGA
#define MEGA 1
#endif

typedef unsigned short u16;
typedef __attribute__((ext_vector_type(8))) short bf16x8;
typedef __attribute__((ext_vector_type(4))) short bf16x4;
typedef __attribute__((ext_vector_type(16))) float f32x16;

constexpr int D = 1024;
constexpr int NTOK = 6144;
constexpr int NCTX = 4096;
constexpr int DEPTH = 4;
constexpr int NIN = 7328;
constexpr int LDP = 7424;
constexpr int DFF = 2816;
constexpr int OFF_KA = 512, OFF_VA = 640, OFF_QB = 768, OFF_KB = 1024, OFF_VB = 1280, OFF_GB = 1792,
              OFF_GKF = 2304, OFF_GKB = 2320, OFF_C = 2336, OFF_GATE = 4256;
constexpr int NTHREADS = 256;

enum { I_XP = 0, I_XS, I_CK, I_CV, I_SG, I_SR, I_C, I_CCTX, I_WADA, I_BADA, I_GMIX, I_GFFN, I_WIN, I_QG, I_KG,
       I_GKW2, I_GKB, I_GLAG, I_MU, I_W0, I_W2, I_A0, I_A2, I_G2, I_KK, I_KA, I_RK, I_LNW, I_LNB,
       I_WPA, I_WPB, I_WPC, I_WOUT, I_WFI, I_WFO, N_INPUTS };

constexpr size_t O_YP = 0, O_YS = 4194304, O_CK = 6291456, O_CV = 8388608, O_SG = 10485760, O_SR = 14680064;

constexpr size_t WB_IN = 0;
constexpr size_t WB_PO = WB_IN + (size_t)LDP * 1024;
constexpr size_t WB_OUT = WB_PO + (size_t)3 * 1024 * 512;
constexpr size_t WB_FI = WB_OUT + (size_t)1024 * 1024;
constexpr size_t WB_FO = WB_FI + (size_t)5632 * 1024;
constexpr size_t WB_LORA = WB_FO + (size_t)1024 * 2816;
constexpr size_t WB_TOTAL = WB_LORA + (size_t)4 * 32768 + 65536;

struct Params {
  const float* in[N_INPUTS];
  float* out;
  u16* wb[2];
  float* mod;
  u16* h;
  u16* p;
  u16* qbuf;
  u16* kctx;
  u16* vtctx;
  u16* klat;
  u16* vtlat;
  u16* gqe;
  u16* gke;
  u16* gklT;
  u16* gvT;
  float* gdl;
  u16* ob;
  u16* obi;
  float* gU;
  u16* rr;
  u16* rv;
  u16* rnkk;
  float* rdec;
  u16* rkd;
  u16* rbk;
  u16* rgc;
  float* rbon;
  float* ry;
  u16* ocat;
  unsigned* bar;
};

__device__ __forceinline__ int ltid() { int t = threadIdx.x; asm volatile("" : "+v"(t)); return t; }
__device__ __forceinline__ int lbid() { int t = blockIdx.x; asm volatile("" : "+s"(t)); return t; }
__device__ __forceinline__ u16 f2bf(float f) {
  unsigned u = __float_as_uint(f);
  u += 0x7fffu + ((u >> 16) & 1u);
  return (u16)(u >> 16);
}
__device__ __forceinline__ float bf2f(u16 b) { return __uint_as_float(((unsigned)b) << 16); }
__device__ __forceinline__ unsigned pack2(float a, float b) { return (unsigned)f2bf(a) | ((unsigned)f2bf(b) << 16); }
__device__ __forceinline__ float sigmoidf_(float x) { return __builtin_amdgcn_rcpf(1.f + __expf(-x)); }
__device__ __forceinline__ float siluf_(float x) { return x * __builtin_amdgcn_rcpf(1.f + __expf(-x)); }
__device__ __forceinline__ float softplusf_(float x) { return fmaxf(x, 0.f) + log1pf(__expf(-fabsf(x))); }

template <int CTRL>
__device__ __forceinline__ float dpp_addf(float x) {
  int xi = __float_as_int(x);
  int yi = __builtin_amdgcn_update_dpp(0, xi, CTRL, 0xF, 0xF, true);
  return x + __int_as_float(yi);
}
template <int N>
__device__ __forceinline__ float group_sum(float x) {
  x = dpp_addf<0xB1>(x);
  x = dpp_addf<0x4E>(x);
  x = dpp_addf<0x141>(x);
  if (N >= 16) x = dpp_addf<0x140>(x);
  if (N >= 32) x += __shfl_xor(x, 16, 64);
  if (N >= 64) x += __shfl_xor(x, 32, 64);
  return x;
}

__device__ __forceinline__ void unpack8(uint4 r, float* v) {
  v[0] = __uint_as_float(r.x << 16); v[1] = __uint_as_float(r.x & 0xffff0000u);
  v[2] = __uint_as_float(r.y << 16); v[3] = __uint_as_float(r.y & 0xffff0000u);
  v[4] = __uint_as_float(r.z << 16); v[5] = __uint_as_float(r.z & 0xffff0000u);
  v[6] = __uint_as_float(r.w << 16); v[7] = __uint_as_float(r.w & 0xffff0000u);
}
__device__ __forceinline__ uint4 pack8(const float* v) {
  uint4 r; r.x = pack2(v[0], v[1]); r.y = pack2(v[2], v[3]); r.z = pack2(v[4], v[5]); r.w = pack2(v[6], v[7]);
  return r;
}
__device__ __forceinline__ float4 unpack4(uint2 r) {
  return make_float4(__uint_as_float(r.x << 16), __uint_as_float(r.x & 0xffff0000u), __uint_as_float(r.y << 16),
                     __uint_as_float(r.y & 0xffff0000u));
}
__device__ __forceinline__ uint2 pack4(float a, float b, float c, float d) { uint2 r; r.x = pack2(a, b); r.y = pack2(c, d); return r; }
__device__ __forceinline__ f32x16 zero16() {
  f32x16 z;
#pragma unroll
  for (int i = 0; i < 16; ++i) z[i] = 0.f;
  return z;
}
__device__ __forceinline__ f32x16 mfma(bf16x8 a, bf16x8 b, f32x16 c) {
  return __builtin_amdgcn_mfma_f32_32x32x16_bf16(a, b, c, 0, 0, 0);
}
__device__ __forceinline__ int accrow(int r, int h) { return (r & 3) + 8 * (r >> 2) + 4 * h; }

__device__ __forceinline__ bf16x8 ld8(const u16* p) { return *reinterpret_cast<const bf16x8*>(p); }
__device__ __forceinline__ bf16x8 ld4x2(const u16* p0, const u16* p1) {
  bf16x4 a = *reinterpret_cast<const bf16x4*>(p0);
  bf16x4 b = *reinterpret_cast<const bf16x4*>(p1);
  bf16x8 r;
  r[0] = a[0]; r[1] = a[1]; r[2] = a[2]; r[3] = a[3]; r[4] = b[0]; r[5] = b[1]; r[6] = b[2]; r[7] = b[3];
  return r;
}
__device__ __forceinline__ bf16x8 acc2frag(const f32x16& x, int s) {
  bf16x8 r;
#pragma unroll
  for (int j = 0; j < 8; ++j) r[j] = (short)f2bf(x[8 * s + j]);
  return r;
}

__device__ __forceinline__ void seq_info(int s, int& base, int& T) {
  if (s < 16) { base = s * 256; T = 256; } else { base = NCTX + (s - 16) * 1024; T = 1024; }
}
__device__ __forceinline__ int cond_of(int m) { return m < NCTX ? 0 : 1 + ((m - NCTX) >> 10); }

__device__ __forceinline__ void convert_tile(const float* __restrict__ src, int Nsrc, u16* __restrict__ dst, int K, int kt, int nt,
                             int kind, char* smem) {
  float* tile = (float*)smem;
  int tid = ltid();
  __syncthreads();
#pragma unroll
  for (int pss = 0; pss < 4; ++pss) {
    int kr = pss * 16 + (tid >> 4);
    int nl = (tid & 15) * 4;
    int scol;
    if (kind == 5) scol = (nl < 32) ? (32 * nt + nl) : (DFF + 32 * nt + nl - 32);
    else scol = nt * 64 + nl;
    float4 v = make_float4(0.f, 0.f, 0.f, 0.f);
    if (scol < Nsrc) v = *reinterpret_cast<const float4*>(src + (size_t)(kt * 64 + kr) * Nsrc + scol);
    tile[kr * 65 + nl + 0] = v.x; tile[kr * 65 + nl + 1] = v.y; tile[kr * 65 + nl + 2] = v.z; tile[kr * 65 + nl + 3] = v.w;
  }
  __syncthreads();
  int n = tid >> 2, ks = (tid & 3) * 16;
  float v[16];
#pragma unroll
  for (int i = 0; i < 16; ++i) v[i] = tile[(ks + i) * 65 + n];
  u16* dp = dst + (size_t)(nt * 64 + n) * K + kt * 64 + ks;
  *reinterpret_cast<uint4*>(dp) = pack8(v);
  *reinterpret_cast<uint4*>(dp + 8) = pack8(v + 8);
}
constexpr int CV_IN = 16 * 116, CV_PO = 8 * 16, CV_OUT = 16 * 16, CV_FI = 16 * 88, CV_FO = 44 * 16;
constexpr int CV_LORA = 4 * 8 + 16;
constexpr int CV_TOTAL = CV_IN + 3 * CV_PO + CV_OUT + CV_FI + CV_FO + CV_LORA;
__device__ __forceinline__ void convert_item(const Params& P, int layer, int it, char* smem) {
  u16* wb = P.wb[layer & 1];
  if (it < CV_IN) { convert_tile(P.in[I_WIN] + (size_t)layer * 1024 * NIN, NIN, wb + WB_IN, 1024, it % 16, it / 16, 0, smem); return; }
  it -= CV_IN;
  if (it < 3 * CV_PO) {
    int w = it / CV_PO, r = it % CV_PO;
    convert_tile(P.in[I_WPA + w] + (size_t)layer * 512 * 1024, 1024, wb + WB_PO + (size_t)w * 1024 * 512, 512, r % 8, r / 8, 1 + w, smem);
    return;
  }
  it -= 3 * CV_PO;
  if (it < CV_OUT) { convert_tile(P.in[I_WOUT] + (size_t)layer * 1024 * 1024, 1024, wb + WB_OUT, 1024, it % 16, it / 16, 4, smem); return; }
  it -= CV_OUT;
  if (it < CV_FI) { convert_tile(P.in[I_WFI] + (size_t)layer * 1024 * 5632, 5632, wb + WB_FI, 1024, it % 16, it / 16, 5, smem); return; }
  it -= CV_FI;
  if (it < CV_FO) { convert_tile(P.in[I_WFO] + (size_t)layer * DFF * 1024, 1024, wb + WB_FO, DFF, it % 44, it / 44, 6, smem); return; }
  it -= CV_FO;
  if (it < 32) {
    int mtx = it >> 3, nt = it & 7;
    const float* src = P.in[(mtx < 2) ? I_W2 : I_A2] + (size_t)(layer * 2 + (mtx & 1)) * 64 * 512;
    convert_tile(src, 512, wb + WB_LORA + (size_t)mtx * 32768, 64, 0, nt, 7, smem);
    return;
  }
  it -= 32;
  convert_tile(P.in[I_G2] + (size_t)layer * 128 * 512, 512, wb + WB_LORA + (size_t)4 * 32768, 128, it & 1, it >> 1, 8, smem);
}

__device__ __forceinline__ void adaln_item(const Params& P, int it, char* smem) {
  int layer = it / 96, nb = it % 96;
  float* sc = (float*)smem;
  float* red = sc + 3072;
  int tid = ltid();
  __syncthreads();
  for (int e = tid; e < 3072; e += NTHREADS) {
    int c = e >> 10, k = e & 1023;
    float v = (c == 0) ? P.in[I_CCTX][k] : P.in[I_C][(c - 1) * 1024 + k];
    sc[e] = siluf_(v);
  }
  __syncthreads();
  int cg4 = (tid & 15) * 4, ks = tid >> 4;
  float acc[3][4];
#pragma unroll
  for (int c = 0; c < 3; ++c)
#pragma unroll
    for (int j = 0; j < 4; ++j) acc[c][j] = 0.f;
  const float* w = P.in[I_WADA] + (size_t)layer * 1024 * 6144 + nb * 64 + cg4;
#pragma unroll 4
  for (int i = 0; i < 64; ++i) {
    int k = i * 16 + ks;
    float4 wv = *reinterpret_cast<const float4*>(w + (size_t)k * 6144);
#pragma unroll
    for (int c = 0; c < 3; ++c) {
      float s = sc[c * 1024 + k];
      acc[c][0] += s * wv.x; acc[c][1] += s * wv.y; acc[c][2] += s * wv.z; acc[c][3] += s * wv.w;
    }
  }
#pragma unroll
  for (int c = 0; c < 3; ++c)
#pragma unroll
    for (int j = 0; j < 4; ++j) red[(ks * 3 + c) * 64 + cg4 + j] = acc[c][j];
  __syncthreads();
  if (tid < 192) {
    int c = tid >> 6, col = tid & 63;
    float s = P.in[I_BADA][layer * 6144 + nb * 64 + col];
#pragma unroll
    for (int k2 = 0; k2 < 16; ++k2) s += red[(k2 * 3 + c) * 64 + col];
    P.mod[((size_t)layer * 3 + c) * 6144 + nb * 64 + col] = s;
  }
}

__device__ __forceinline__ void cache_item(const Params& P, int it) {
  int e = it * NTHREADS + ltid();
  int d = e & 63, kvh = (e >> 6) & 1, key = (e >> 7) & 255, l = (e >> 15) & 3, b = e >> 17;
  float kv = P.in[I_CK][e], vv = P.in[I_CV][e];
  size_t hb = ((size_t)(l * 2 + b) * 2 + kvh);
  P.klat[(hb * 1280 + key) * 64 + d] = f2bf(kv);
  P.vtlat[(hb * 64 + d) * 1280 + key] = f2bf(vv);
}

__device__ __forceinline__ void norm_item(const Params& P, int layer, int which, int it) {
  int lane = ltid() & 63, wave = ltid() >> 6;
  int m = it * 4 + wave;
  const float* xrow;
  if (which == 0 && layer == 0) xrow = (m < NCTX) ? P.in[I_XP] + (size_t)m * D : P.in[I_XS] + (size_t)(m - NCTX) * D;
  else xrow = P.out + (size_t)m * D;
  const float* g = P.in[which ? I_GFFN : I_GMIX] + layer * D;
  const float* md = P.mod + ((size_t)layer * 3 + cond_of(m)) * 6144 + (which ? 3 * D : 0);
  float4 xv[4];
  float ss = 0.f;
#pragma unroll
  for (int i = 0; i < 4; ++i) {
    xv[i] = *reinterpret_cast<const float4*>(xrow + i * 256 + lane * 4);
    ss += xv[i].x * xv[i].x + xv[i].y * xv[i].y + xv[i].z * xv[i].z + xv[i].w * xv[i].w;
  }
  ss = group_sum<64>(ss);
  float rs = rsqrtf(ss * (1.f / 1024.f) + 1e-6f);
#pragma unroll
  for (int i = 0; i < 4; ++i) {
    int c = i * 256 + lane * 4;
    float4 gv = *reinterpret_cast<const float4*>(g + c);
    float4 sh = *reinterpret_cast<const float4*>(md + c);
    float4 scv = *reinterpret_cast<const float4*>(md + D + c);
    float a0 = xv[i].x * rs * gv.x * (1.f + scv.x) + sh.x;
    float a1 = xv[i].y * rs * gv.y * (1.f + scv.y) + sh.y;
    float a2 = xv[i].z * rs * gv.z * (1.f + scv.z) + sh.z;
    float a3 = xv[i].w * rs * gv.w * (1.f + scv.w) + sh.w;
    uint2 o; o.x = pack2(a0, a1); o.y = pack2(a2, a3);
    *reinterpret_cast<uint2*>(P.h + (size_t)m * D + c) = o;
  }
}

__device__ __forceinline__ void glds16(const u16* g, char* l) {
  __builtin_amdgcn_global_load_lds((const unsigned*)g, (__attribute__((address_space(3))) unsigned*)l, 16, 0, 0);
}
template <int BM, int BN, int WM, int WN>
__device__ __forceinline__ void gemm_core(const u16* __restrict__ A, int lda, const u16* __restrict__ B, int ldb, int K,
                                          int m0, int n0, char* smem, f32x16 (&acc)[BM / (32 * WM)][BN / (32 * WN)]) {
  constexpr int NA = BM / 32;
  constexpr int NB = BN / 32;
  constexpr int MI = BM / (32 * WM), NI = BN / (32 * WN);
  const u16* sA = (const u16*)smem;
  const u16* sB = sA + 2 * 128 * 64;
  const int tid = ltid(), lane = tid & 63, wave = tid >> 6;
  const int wm = wave / WN, wn = wave % WN;
  const int lr = tid >> 3, lc = tid & 7;
  const u16* Ap = A + (size_t)(m0 + lr) * lda + ((lc ^ (lr & 7)) << 3);
  const u16* Bp = B + (size_t)(n0 + lr) * ldb + ((lc ^ (lr & 7)) << 3);
  char* lA = smem + tid * 16;
  char* lB = smem + 32768 + tid * 16;
  const int nk = K >> 6;
  __syncthreads();
#pragma unroll
  for (int i = 0; i < NA; ++i) glds16(Ap + (size_t)i * 32 * lda, lA + i * 4096);
#pragma unroll
  for (int i = 0; i < NB; ++i) glds16(Bp + (size_t)i * 32 * ldb, lB + i * 4096);
  asm volatile("s_waitcnt vmcnt(0)" ::: "memory");
  __syncthreads();
  const int r31 = lane & 31, hh = lane >> 5;
  for (int kt = 0; kt < nk; ++kt) {
    const int cur = kt & 1;
    if (kt + 1 < nk) {
#pragma unroll
      for (int i = 0; i < NA; ++i) glds16(Ap + (size_t)i * 32 * lda + (kt + 1) * 64, lA + (cur ^ 1) * (BM * 128) + i * 4096);
#pragma unroll
      for (int i = 0; i < NB; ++i) glds16(Bp + (size_t)i * 32 * ldb + (kt + 1) * 64, lB + (cur ^ 1) * (BN * 128) + i * 4096);
    }
    const u16* cA = sA + cur * BM * 64;
    const u16* cB = sB + cur * BN * 64;
    bf16x8 af[2][MI], bfr[2][NI];
#pragma unroll
    for (int mi = 0; mi < MI; ++mi) {
      int row = wm * (BM / WM) + mi * 32 + r31;
      af[0][mi] = ld8(cA + row * 64 + ((hh ^ (row & 7)) << 3));
    }
#pragma unroll
    for (int ni = 0; ni < NI; ++ni) {
      int row = wn * (BN / WN) + ni * 32 + r31;
      bfr[0][ni] = ld8(cB + row * 64 + ((hh ^ (row & 7)) << 3));
    }
#pragma unroll
    for (int ks = 0; ks < 4; ++ks) {
      if (ks + 1 < 4) {
#pragma unroll
        for (int mi = 0; mi < MI; ++mi) {
          int row = wm * (BM / WM) + mi * 32 + r31;
          af[(ks + 1) & 1][mi] = ld8(cA + row * 64 + ((((ks + 1) * 2 + hh) ^ (row & 7)) << 3));
        }
#pragma unroll
        for (int ni = 0; ni < NI; ++ni) {
          int row = wn * (BN / WN) + ni * 32 + r31;
          bfr[(ks + 1) & 1][ni] = ld8(cB + row * 64 + ((((ks + 1) * 2 + hh) ^ (row & 7)) << 3));
        }
      }
#pragma unroll
      for (int mi = 0; mi < MI; ++mi)
#pragma unroll
        for (int ni = 0; ni < NI; ++ni) acc[mi][ni] = mfma(af[ks & 1][mi], bfr[ks & 1][ni], acc[mi][ni]);
    }
    asm volatile("s_waitcnt vmcnt(0)" ::: "memory");
    __syncthreads();
  }
}

__device__ __forceinline__ bool tile_coords(int iter, int mt, int nt, int& tm, int& tn) {
  int G = gridDim.x, b = lbid();
  int t;
  if ((G & 7) == 0) {
    int nloc = G >> 3;
    t = ((iter * 8 + (b & 7)) * nloc) + (b >> 3);
  } else {
    t = iter * G + b;
  }
  int total = mt * nt;
  if (t >= total) return false;
  int full = nt >> 3;
  int fullTiles = full * mt * 8;
  if (t < fullTiles) {
    int band = t / (mt * 8), rem = t % (mt * 8);
    int g = rem >> 6, i = rem & 63;
    tm = g * 8 + (i & 7);
    tn = band * 8 + (i >> 3);
  } else {
    int rem = t - fullTiles;
    tm = rem % mt;
    tn = full * 8 + rem / mt;
  }
  return true;
}
__device__ __forceinline__ int tile_iters(int mt, int nt) {
  int G = gridDim.x;
  int total = mt * nt;
  if ((G & 7) == 0) {
    int nloc = G >> 3;
    int chunks = (total + nloc - 1) / nloc;
    return (chunks + 7) / 8;
  }
  return (total + G - 1) / G;
}

__device__ __forceinline__ void gemm_in_phase(const Params& P, int layer, char* smem) {
  const u16* W = P.wb[layer & 1] + WB_IN;
  const int mt = NTOK / 128, nt = LDP / 128;
  const int lane = ltid() & 63, wave = ltid() >> 6, wm = wave >> 1, wn = wave & 1;
  int iters = tile_iters(mt, nt);
  for (int it = 0; it < iters; ++it) {
    int tm, tn;
    if (!tile_coords(it, mt, nt, tm, tn)) continue;
    f32x16 acc[2][2];
#pragma unroll
    for (int a = 0; a < 2; ++a)
#pragma unroll
      for (int b = 0; b < 2; ++b) acc[a][b] = zero16();
    gemm_core<128, 128, 2, 2>(P.h, D, W, D, D, tm * 128, tn * 128, smem, acc);
#pragma unroll
    for (int mi = 0; mi < 2; ++mi)
#pragma unroll
      for (int ni = 0; ni < 2; ++ni)
#pragma unroll
        for (int r = 0; r < 16; ++r) {
          int row = tm * 128 + wm * 64 + mi * 32 + accrow(r, lane >> 5);
          int col = tn * 128 + wn * 64 + ni * 32 + (lane & 31);
          P.p[(size_t)row * LDP + col] = f2bf(acc[mi][ni][r]);
        }
  }
}

__device__ __forceinline__ void gemm_po_phase(const Params& P, int layer, char* smem) {
  const u16* W = P.wb[layer & 1] + WB_PO;
  const int mt = NTOK / 96, nt = D / 128;
  const int lane = ltid() & 63, wave = ltid() >> 6;
  int iters = tile_iters(mt, nt);
  for (int it = 0; it < iters; ++it) {
    int tm, tn;
    if (!tile_coords(it, mt, nt, tm, tn)) continue;
    f32x16 tot[3];
    tot[0] = zero16(); tot[1] = zero16(); tot[2] = zero16();
    const int col = tn * 128 + wave * 32 + (lane & 31);
    for (int br = 0; br < 3; ++br) {
      f32x16 acc[3][1];
      acc[0][0] = zero16(); acc[1][0] = zero16(); acc[2][0] = zero16();
      gemm_core<96, 128, 1, 4>(P.ocat + br * 512, 1536, W + (size_t)br * 1024 * 512, 512, 512, tm * 96, tn * 128, smem, acc);
      const u16* gp = P.p + (size_t)(tm * 96 + 4 * (lane >> 5)) * LDP + OFF_GATE + br * D + col;
#pragma unroll
      for (int mi = 0; mi < 3; ++mi) {
#pragma unroll
        for (int q = 0; q < 4; ++q) {
          const u16* gq = gp + (size_t)(mi * 32 + 8 * q) * LDP;
          float g0 = sigmoidf_(bf2f(gq[0])), g1 = sigmoidf_(bf2f(gq[LDP])), g2 = sigmoidf_(bf2f(gq[2 * LDP])),
                g3 = sigmoidf_(bf2f(gq[3 * LDP]));
          tot[mi][4 * q + 0] += g0 * acc[mi][0][4 * q + 0];
          tot[mi][4 * q + 1] += g1 * acc[mi][0][4 * q + 1];
          tot[mi][4 * q + 2] += g2 * acc[mi][0][4 * q + 2];
          tot[mi][4 * q + 3] += g3 * acc[mi][0][4 * q + 3];
          __builtin_amdgcn_sched_barrier(0);
        }
      }
    }
#pragma unroll
    for (int mi = 0; mi < 3; ++mi)
#pragma unroll
      for (int r = 0; r < 16; ++r) {
        int row = tm * 96 + mi * 32 + accrow(r, lane >> 5);
        P.h[(size_t)row * D + col] = f2bf(tot[mi][r]);
      }
  }
}

__device__ __forceinline__ void gemm_res_phase(const Params& P, int layer, int which, char* smem) {
  const u16* A; const u16* W; int K, lda;
  if (which == 0) { A = P.h; lda = D; W = P.wb[layer & 1] + WB_OUT; K = D; }
  else { A = P.p; lda = DFF; W = P.wb[layer & 1] + WB_FO; K = DFF; }
  const int mt = NTOK / 96, nt = D / 128;
  const int lane = ltid() & 63, wave = ltid() >> 6;
  int iters = tile_iters(mt, nt);
  for (int it = 0; it < iters; ++it) {
    int tm, tn;
    if (!tile_coords(it, mt, nt, tm, tn)) continue;
    f32x16 acc[3][1];
    acc[0][0] = zero16(); acc[1][0] = zero16(); acc[2][0] = zero16();
    gemm_core<96, 128, 1, 4>(A, lda, W, K, K, tm * 96, tn * 128, smem, acc);
    const int col = tn * 128 + wave * 32 + (lane & 31);
#pragma unroll
    for (int mi = 0; mi < 3; ++mi)
#pragma unroll
      for (int r = 0; r < 16; ++r) {
        int row = tm * 96 + mi * 32 + accrow(r, lane >> 5);
        const float* xin;
        if (which == 0 && layer == 0) xin = (row < NCTX) ? P.in[I_XP] + (size_t)row * D : P.in[I_XS] + (size_t)(row - NCTX) * D;
        else xin = P.out + (size_t)row * D;
        float gt = P.mod[((size_t)layer * 3 + cond_of(row)) * 6144 + (which ? 5 * D : 2 * D) + col];
        P.out[(size_t)row * D + col] = xin[col] + gt * acc[mi][0][r];
      }
  }
}

__device__ __forceinline__ void gemm_ffi_phase(const Params& P, int layer, char* smem) {
  const u16* W = P.wb[layer & 1] + WB_FI;
  const int mt = NTOK / 128, nt = 5632 / 128;
  const int lane = ltid() & 63, wave = ltid() >> 6, wm = wave >> 1, wn = wave & 1;
  u16* act = P.p;
  int iters = tile_iters(mt, nt);
  for (int it = 0; it < iters; ++it) {
    int tm, tn;
    if (!tile_coords(it, mt, nt, tm, tn)) continue;
    f32x16 acc[2][2];
#pragma unroll
    for (int a = 0; a < 2; ++a)
#pragma unroll
      for (int b = 0; b < 2; ++b) acc[a][b] = zero16();
    gemm_core<128, 128, 2, 2>(P.h, D, W, D, D, tm * 128, tn * 128, smem, acc);
    int j = tn * 2 + wn;
#pragma unroll
    for (int mi = 0; mi < 2; ++mi)
#pragma unroll
      for (int r = 0; r < 16; ++r) {
        int row = tm * 128 + wm * 64 + mi * 32 + accrow(r, lane >> 5);
        int col = j * 32 + (lane & 31);
        act[(size_t)row * DFF + col] = f2bf(siluf_(acc[mi][0][r]) * acc[mi][1][r]);
      }
  }
}

__device__ __forceinline__ void rope8(float* v, int d0, int t) {
  float row = (float)(t >> 6), col = (float)(t & 63);
#pragma unroll
  for (int i = 0; i < 4; ++i) {
    int pi = (d0 >> 1) + i;
    float pos = (pi < 16) ? row : col;
    float inv = exp2f(-(float)(pi & 15) * (13.287712379549449f / 16.f));
    float ang = pos * inv;
    float n = rintf(ang * 0.15915494309189535f);
    float rr = fmaf(-n, 6.2831855f, ang);
    rr = fmaf(-n, -1.7484555e-7f, rr);
    float sn = __sinf(rr), cs = __cosf(rr);
    float x0 = v[2 * i], x1 = v[2 * i + 1];
    v[2 * i] = x0 * cs - x1 * sn;
    v[2 * i + 1] = x0 * sn + x1 * cs;
  }
}

__device__ __forceinline__ void attn_prep_item(const Params& P, int layer, int it) {
  int lane = ltid() & 63, wave = ltid() >> 6;
  int m = it * 4 + wave;
  const u16* prow = P.p + (size_t)m * LDP;
  bool lat = m >= NCTX;
  int b, t;
  if (!lat) { b = m >> 8; t = m & 255; } else { b = (m - NCTX) >> 10; t = (m - NCTX) & 1023; }
  {
    float v[8];
    unpack8(*reinterpret_cast<const uint4*>(prow + lane * 8), v);
    float ss = 0.f;
#pragma unroll
    for (int i = 0; i < 8; ++i) ss += v[i] * v[i];
    ss = group_sum<8>(ss);
    float rs = rsqrtf(ss * (1.f / 64.f) + 1e-6f);
    int d0 = (lane & 7) * 8;
#pragma unroll
    for (int i = 0; i < 8; ++i) v[i] = v[i] * rs * P.in[I_QG][layer * 64 + d0 + i];
    if (lat) rope8(v, d0, t);
    *reinterpret_cast<uint4*>(P.qbuf + (size_t)m * 512 + lane * 8) = pack8(v);
  }
  {
    int l2 = lane & 31;
    float v[8];
    unpack8(*reinterpret_cast<const uint4*>(prow + OFF_KA + l2 * 8), v);
    float ss = 0.f;
#pragma unroll
    for (int i = 0; i < 8; ++i) ss += v[i] * v[i];
    ss = group_sum<8>(ss);
    int d0 = (l2 & 7) * 8;
    int kvh = (l2 >> 3) & 1;
    if (l2 < 16) {
      float rs = rsqrtf(ss * (1.f / 64.f) + 1e-6f);
#pragma unroll
      for (int i = 0; i < 8; ++i) v[i] = v[i] * rs * P.in[I_KG][layer * 64 + d0 + i];
      if (!lat) {
        if (lane < 32) {
          float* ok = P.out + O_CK + (((size_t)(b * 4 + layer) * 256 + t) * 2 + kvh) * 64 + d0;
          *reinterpret_cast<float4*>(ok) = make_float4(v[0], v[1], v[2], v[3]);
          *reinterpret_cast<float4*>(ok + 4) = make_float4(v[4], v[5], v[6], v[7]);
          *reinterpret_cast<uint4*>(P.kctx + (((size_t)(b * 2 + kvh)) * 256 + t) * 64 + d0) = pack8(v);
        }
      } else {
        rope8(v, d0, t);
        if (lane < 32)
          *reinterpret_cast<uint4*>(P.klat + ((((size_t)(layer * 2 + b)) * 2 + kvh) * 1280 + 256 + t) * 64 + d0) = pack8(v);
      }
    } else {
      if (lane < 32) {
        if (!lat) {
          float* ov = P.out + O_CV + (((size_t)(b * 4 + layer) * 256 + t) * 2 + kvh) * 64 + d0;
          *reinterpret_cast<float4*>(ov) = make_float4(v[0], v[1], v[2], v[3]);
          *reinterpret_cast<float4*>(ov + 4) = make_float4(v[4], v[5], v[6], v[7]);
          u16* vt = P.vtctx + ((size_t)(b * 2 + kvh) * 64 + d0) * 256 + t;
#pragma unroll
          for (int i = 0; i < 8; ++i) vt[i * 256] = f2bf(v[i]);
        } else {
          u16* vt = P.vtlat + ((((size_t)(layer * 2 + b)) * 2 + kvh) * 64 + d0) * 1280 + 256 + t;
#pragma unroll
          for (int i = 0; i < 8; ++i) vt[i * 1280] = f2bf(v[i]);
        }
      }
    }
  }
}

__device__ __forceinline__ void gla_prep_item(const Params& P, int layer, int it, char* smem) {
  int chunk = it >> 2, h = it & 3;
  int m0 = chunk * 64;
  int tid = ltid();
  float* bc = (float*)smem;
  u16* sq = (u16*)(smem + 32768);
  u16* sk = sq + 4096;
  u16* slr = sk + 4096;
  __syncthreads();
  {
    int row = tid >> 2, seg = (tid & 3) * 16;
    const u16* pr = P.p + (size_t)(m0 + row) * LDP;
    *reinterpret_cast<uint4*>(sq + row * 64 + seg) = *reinterpret_cast<const uint4*>(pr + OFF_QB + h * 64 + seg);
    *reinterpret_cast<uint4*>(sq + row * 64 + seg + 8) = *reinterpret_cast<const uint4*>(pr + OFF_QB + h * 64 + seg + 8);
    *reinterpret_cast<uint4*>(sk + row * 64 + seg) = *reinterpret_cast<const uint4*>(pr + OFF_KB + h * 64 + seg);
    *reinterpret_cast<uint4*>(sk + row * 64 + seg + 8) = *reinterpret_cast<const uint4*>(pr + OFF_KB + h * 64 + seg + 8);
    int part = tid & 3;
    *reinterpret_cast<uint4*>(slr + ((part >> 1) * 64 + row) * 16 + (part & 1) * 8) =
        *reinterpret_cast<const uint4*>(pr + OFF_GKF + part * 8);
  }
  __syncthreads();
  {
    int dk = tid & 63, tg = tid >> 6;
#pragma unroll
    for (int dir = 0; dir < 2; ++dir) {
      float w[16];
#pragma unroll
      for (int r = 0; r < 16; ++r) w[r] = P.in[I_GKW2][((size_t)(layer * 2 + dir) * 16 + r) * 256 + h * 64 + dk];
      float bias = P.in[I_GKB][(layer * 2 + dir) * 256 + h * 64 + dk];
      for (int tt = 0; tt < 16; ++tt) {
        int t = tg * 16 + tt;
        float z = bias;
#pragma unroll
        for (int r = 0; r < 16; ++r) z += bf2f(slr[(dir * 64 + t) * 16 + r]) * w[r];
        float ls = fminf(z, 0.f) - __logf(1.f + __expf(-fabsf(z)));
        bc[(dir * 64 + t) * 64 + dk] = ls * (1.f / 16.f);
      }
    }
  }
  __syncthreads();
  if (tid < 128) {
    int dk = tid & 63, dir = tid >> 6;
    float run = 0.f;
    if (dir == 0) { for (int t = 0; t < 64; ++t) { run += bc[t * 64 + dk]; bc[t * 64 + dk] = run; } }
    else { for (int t = 63; t >= 0; --t) { run += bc[(64 + t) * 64 + dk]; bc[(64 + t) * 64 + dk] = run; } }
  }
  __syncthreads();
  {
    int t = tid >> 2, seg = (tid & 3) * 16;
#pragma unroll
    for (int dir = 0; dir < 2; ++dir) {
      float qv[16], kv[16];
#pragma unroll
      for (int i = 0; i < 16; ++i) {
        float bb = bc[(dir * 64 + t) * 64 + seg + i];
        qv[i] = bf2f(sq[t * 64 + seg + i]) * 0.125f * __expf(bb);
        kv[i] = bf2f(sk[t * 64 + seg + i]) * __expf(-bb);
      }
      size_t o = ((size_t)dir * NTOK + m0 + t) * 256 + h * 64 + seg;
      *reinterpret_cast<uint4*>(P.gqe + o) = pack8(qv);
      *reinterpret_cast<uint4*>(P.gqe + o + 8) = pack8(qv + 8);
      *reinterpret_cast<uint4*>(P.gke + o) = pack8(kv);
      *reinterpret_cast<uint4*>(P.gke + o + 8) = pack8(kv + 8);
    }
  }
  {
    int dk = tid >> 2, iseg = (tid & 3) * 16;
#pragma unroll
    for (int dir = 0; dir < 2; ++dir) {
      float blast = bc[(dir * 64 + (dir ? 0 : 63)) * 64 + dk];
      float kv[16];
#pragma unroll
      for (int ii = 0; ii < 16; ++ii) {
        int i = iseg + ii;
        int t = dir ? 63 - i : i;
        kv[ii] = bf2f(sk[t * 64 + dk]) * __expf(blast - bc[(dir * 64 + t) * 64 + dk]);
      }
      size_t o = ((((size_t)dir * 96 + chunk) * 4 + h) * 64 + dk) * 64 + iseg;
      *reinterpret_cast<uint4*>(P.gklT + o) = pack8(kv);
      *reinterpret_cast<uint4*>(P.gklT + o + 8) = pack8(kv + 8);
      if ((tid & 3) == 0) P.gdl[((size_t)dir * 96 + chunk) * 256 + h * 64 + dk] = __expf(blast);
    }
  }
  {
    int dv = tid >> 1, iseg = (tid & 1) * 32;
#pragma unroll
    for (int dir = 0; dir < 2; ++dir) {
      size_t o = ((((size_t)dir * 96 + chunk) * 4 + h) * 128 + dv) * 64 + iseg;
#pragma unroll
      for (int g = 0; g < 4; ++g) {
        unsigned w[4];
#pragma unroll
        for (int q = 0; q < 4; ++q) {
          int i0 = iseg + g * 8 + q * 2;
          int t0 = dir ? 63 - i0 : i0, t1 = dir ? 63 - (i0 + 1) : i0 + 1;
          unsigned a = P.p[(size_t)(m0 + t0) * LDP + OFF_VB + h * 128 + dv];
          unsigned b2 = P.p[(size_t)(m0 + t1) * LDP + OFF_VB + h * 128 + dv];
          w[q] = a | (b2 << 16);
        }
        *reinterpret_cast<uint4*>(P.gvT + o + g * 8) = make_uint4(w[0], w[1], w[2], w[3]);
      }
    }
  }
  asm volatile("s_waitcnt vmcnt(0)" ::: "memory");
  __syncthreads();
  {
    const int lane = tid & 63, wave = tid >> 6;
    const int r31 = lane & 31, hh = lane >> 5;
    const int dv = wave * 32 + r31;
#pragma unroll 1
    for (int dir = 0; dir < 2; ++dir) {
      const u16* qeb = P.gqe + (size_t)dir * NTOK * 256 + h * 64;
      const u16* keb = P.gke + (size_t)dir * NTOK * 256 + h * 64;
      u16* ob = P.ob + (size_t)dir * NTOK * 512 + h * 128 + dv;
      const int tokA0 = m0 + (dir ? 63 - r31 : r31);
      const int tokA1 = m0 + (dir ? 31 - r31 : 32 + r31);
      const u16* vT = P.gvT + ((((size_t)dir * 96 + chunk) * 4 + h) * 128 + dv) * 64;
      const u16* klT = P.gklT + ((((size_t)dir * 96 + chunk) * 4 + h) * 64) * 64;
      f32x16 X00 = zero16(), X01 = zero16(), X11 = zero16();
#pragma unroll
      for (int ks = 0; ks < 4; ++ks) {
        bf16x8 k0 = ld8(keb + (size_t)tokA0 * 256 + ks * 16 + hh * 8);
        bf16x8 k1 = ld8(keb + (size_t)tokA1 * 256 + ks * 16 + hh * 8);
        bf16x8 q0 = ld8(qeb + (size_t)tokA0 * 256 + ks * 16 + hh * 8);
        bf16x8 q1 = ld8(qeb + (size_t)tokA1 * 256 + ks * 16 + hh * 8);
        X00 = mfma(k0, q0, X00);
        X01 = mfma(k0, q1, X01);
        X11 = mfma(k1, q1, X11);
      }
#pragma unroll
      for (int r = 0; r < 16; ++r) {
        bool keep = accrow(r, hh) <= r31;
        X00[r] = keep ? X00[r] : 0.f;
        X11[r] = keep ? X11[r] : 0.f;
      }
#pragma unroll 1
      for (int tt = 0; tt < 2; ++tt) {
        f32x16 O = zero16();
#pragma unroll
        for (int sx = 0; sx < 2; ++sx) {
          const u16* vp = vT + 16 * sx + 4 * hh;
          bf16x8 v0 = ld4x2(vp, vp + 8);
          if (tt == 0) {
            O = mfma(acc2frag(X00, sx), v0, O);
          } else {
            bf16x8 v1 = ld4x2(vp + 32, vp + 40);
            O = mfma(acc2frag(X01, sx), v0, O);
            O = mfma(acc2frag(X11, sx), v1, O);
          }
        }
#pragma unroll
        for (int r = 0; r < 16; ++r) {
          int i = tt * 32 + accrow(r, hh);
          int tok = m0 + (dir ? 63 - i : i);
          ob[(size_t)tok * 512] = f2bf(O[r]);
        }
      }
      float* gu = P.gU + ((((size_t)dir * 96 + chunk) * 4 + h) * 128 + dv) * 64 + 4 * hh;
#pragma unroll
      for (int d2 = 0; d2 < 2; ++d2) {
        f32x16 U = zero16();
#pragma unroll
        for (int ks = 0; ks < 4; ++ks) {
          bf16x8 a = ld8(klT + (size_t)(d2 * 32 + r31) * 64 + ks * 16 + hh * 8);
          bf16x8 b2 = ld8(vT + ks * 16 + hh * 8);
          U = mfma(a, b2, U);
        }
#pragma unroll
        for (int g = 0; g < 4; ++g)
          *reinterpret_cast<float4*>(gu + d2 * 32 + 8 * g) = make_float4(U[4 * g], U[4 * g + 1], U[4 * g + 2], U[4 * g + 3]);
      }
    }
  }
}

__device__ __forceinline__ float tanhf_(float x) { return 1.f - 2.f * __builtin_amdgcn_rcpf(__expf(2.f * x) + 1.f); }
__device__ __forceinline__ float pick4(const float4& v, int j) { return j == 0 ? v.x : (j == 1 ? v.y : (j == 2 ? v.z : v.w)); }
__device__ __forceinline__ void rwkv_prep_item(const Params& P, int layer, int it, char* smem) {
  const int tt = it >> 2, hp = it & 3;
  const int m0 = tt * 32;
  int sbase, T;
  { int s = m0 < NCTX ? (m0 >> 8) : 16 + ((m0 - NCTX) >> 10); seq_info(s, sbase, T); }
  const int tid = ltid(), lane = tid & 63, wave = tid >> 6;
  constexpr int LS = 392;
  u16* lin = (u16*)smem;
  const float* mu = P.in[I_MU] + layer * 1920;
  __syncthreads();
#pragma unroll 1
  for (int half = 0; half < 1; ++half) {
    uint4 lu[6], lp[6], ln[6];
    const uint4 z4 = make_uint4(0u, 0u, 0u, 0u);
#pragma unroll
    for (int q = 0; q < 6; ++q) {
      int g = tid + (half * 6 + q) * NTHREADS;
      int tk = g / 48, cg8 = g % 48;
      int m = m0 + tk, t = m - sbase;
      const u16* pr = P.p + (size_t)m * LDP + OFF_C + 1536 + cg8 * 8;
      lu[q] = *reinterpret_cast<const uint4*>(pr);
      lp[q] = (t > 0) ? *reinterpret_cast<const uint4*>(pr - LDP) : z4;
      ln[q] = (t < T - 1) ? *reinterpret_cast<const uint4*>(pr + LDP) : z4;
    }
#pragma unroll
    for (int q = 0; q < 6; ++q) {
      int g = tid + (half * 6 + q) * NTHREADS;
      int tk = g / 48, cg8 = g % 48;
      float u[8], pv[8], nx[8], o[8];
      unpack8(lu[q], u); unpack8(lp[q], pv); unpack8(ln[q], nx);
      float4 mu0 = *reinterpret_cast<const float4*>(mu + 1536 + cg8 * 8);
      float4 mu1 = *reinterpret_cast<const float4*>(mu + 1536 + cg8 * 8 + 4);
      float mus[8] = {mu0.x, mu0.y, mu0.z, mu0.w, mu1.x, mu1.y, mu1.z, mu1.w};
      const float sa_ = (cg8 < 16) ? 2.f : 1.f, sc_ = (cg8 < 16) ? -1.f : 0.f;
      const bool ident = (cg8 >= 16) && (cg8 < 32);
#pragma unroll
      for (int i = 0; i < 8; ++i) {
        float pc = u[i] + mus[i] * (0.5f * (pv[i] + nx[i]) - u[i]);
        float sg = __builtin_amdgcn_rcpf(1.f + __expf(-sa_ * pc));
        o[i] = ident ? pc : (sa_ * sg + sc_);
      }
      *reinterpret_cast<uint4*>(lin + tk * LS + cg8 * 8) = pack8(o);
    }
  }
  __syncthreads();
  const int hsub = wave >> 1, chh = wave & 1;
  const int hq = hp * 2 + hsub;
  const int r31 = lane & 31, hh = lane >> 5;
  f32x16 acc[5];
#pragma unroll
  for (int q = 0; q < 5; ++q) acc[q] = zero16();
  {
    const u16* wl = P.wb[layer & 1] + WB_LORA;
    const int cw = hq * 64 + chh * 32 + r31;
    const u16* lrow = lin + r31 * LS + hh * 8;
#pragma unroll
    for (int q = 0; q < 4; ++q)
#pragma unroll
      for (int ks = 0; ks < 4; ++ks)
        acc[q] = mfma(ld8(wl + (size_t)q * 32768 + cw * 64 + ks * 16 + hh * 8), ld8(lrow + q * 64 + ks * 16), acc[q]);
#pragma unroll
    for (int ks = 0; ks < 8; ++ks)
      acc[4] = mfma(ld8(wl + (size_t)4 * 32768 + cw * 128 + ks * 16 + hh * 8), ld8(lrow + 256 + ks * 16), acc[4]);
  }
  __syncthreads();
  u16* raw = (u16*)smem + hsub * 6528;
  float* red = (float*)(smem + 32768) + hsub * 128;
  {
    uint4 sv[7];
#pragma unroll
    for (int q = 0; q < 7; ++q) {
      int g = tid + q * NTHREADS;
      int hs = g / 816, g2 = g % 816;
      int part = (g2 >> 3) % 3, rr = g2 / 24, chunk = g2 & 7;
      int m = m0 - 1 + rr, t = m - sbase;
      sv[q] = make_uint4(0u, 0u, 0u, 0u);
      if (g < 2 * 34 * 24 && t >= 0 && t < T)
        sv[q] = *reinterpret_cast<const uint4*>(P.p + (size_t)m * LDP + OFF_C + part * 512 + (hp * 2 + hs) * 64 + chunk * 8);
    }
#pragma unroll
    for (int q = 0; q < 7; ++q) {
      int g = tid + q * NTHREADS;
      int hs = g / 816, g2 = g % 816;
      int part = (g2 >> 3) % 3, rr = g2 / 24, chunk = g2 & 7;
      if (g < 2 * 34 * 24) *reinterpret_cast<uint4*>((u16*)smem + hs * 6528 + (rr * 3 + part) * 64 + chunk * 8) = sv[q];
    }
  }
  __syncthreads();
  const int tl = r31;
  const int m = m0 + tl;
  float kkf[16], aF[16], aB[16];
  float ssq = 0.f, bon = 0.f;
#pragma unroll
  for (int g4 = 0; g4 < 4; ++g4) {
    const int cl0 = chh * 32 + 8 * g4 + 4 * hh;
    const int c0 = hq * 64 + cl0;
    const float4 w0f = *reinterpret_cast<const float4*>(P.in[I_W0] + (layer * 2 + 0) * 512 + c0);
    const float4 w0b = *reinterpret_cast<const float4*>(P.in[I_W0] + (layer * 2 + 1) * 512 + c0);
    const float4 a0f = *reinterpret_cast<const float4*>(P.in[I_A0] + (layer * 2 + 0) * 512 + c0);
    const float4 a0b = *reinterpret_cast<const float4*>(P.in[I_A0] + (layer * 2 + 1) * 512 + c0);
    const float4 kkc = *reinterpret_cast<const float4*>(P.in[I_KK] + layer * 512 + c0);
    const float4 kac = *reinterpret_cast<const float4*>(P.in[I_KA] + layer * 512 + c0);
    const float4 rkc = *reinterpret_cast<const float4*>(P.in[I_RK] + layer * 512 + c0);
    const float4 mur = *reinterpret_cast<const float4*>(mu + c0);
    const float4 muk = *reinterpret_cast<const float4*>(mu + 512 + c0);
    const float4 muv = *reinterpret_cast<const float4*>(mu + 1024 + c0);
    float sh[3][4];
#pragma unroll
    for (int part = 0; part < 3; ++part) {
      uint2 pu = *reinterpret_cast<const uint2*>(raw + ((tl + 0) * 3 + part) * 64 + cl0);
      uint2 cu = *reinterpret_cast<const uint2*>(raw + ((tl + 1) * 3 + part) * 64 + cl0);
      uint2 nu = *reinterpret_cast<const uint2*>(raw + ((tl + 2) * 3 + part) * 64 + cl0);
      unsigned pw[2] = {pu.x, pu.y}, cw2[2] = {cu.x, cu.y}, nw[2] = {nu.x, nu.y};
#pragma unroll
      for (int j = 0; j < 4; ++j) {
        float uu = bf2f((u16)(cw2[j >> 1] >> (16 * (j & 1))));
        float pp = bf2f((u16)(pw[j >> 1] >> (16 * (j & 1))));
        float nn = bf2f((u16)(nw[j >> 1] >> (16 * (j & 1))));
        float muj = pick4(part == 0 ? mur : (part == 1 ? muk : muv), j);
        sh[part][j] = uu + muj * (0.5f * (pp + nn) - uu);
      }
    }
    float o_dec[2][4], o_kd[2][4], o_gc[4];
#pragma unroll
    for (int j = 0; j < 4; ++j) {
      const int r = 4 * g4 + j;
      float rv = sh[0][j], kv = sh[1][j];
      float af = sigmoidf_(pick4(a0f, j) + acc[2][r]);
      float ab = sigmoidf_(pick4(a0b, j) + acc[3][r]);
      float wlf = pick4(w0f, j) + acc[0][r];
      float wlb = pick4(w0b, j) + acc[1][r];
      o_dec[0][j] = __expf(-0.6065306597126334f * sigmoidf_(wlf));
      o_dec[1][j] = __expf(-0.6065306597126334f * sigmoidf_(wlb));
      float ka = pick4(kac, j);
      o_kd[0][j] = kv * (1.f + (af - 1.f) * ka);
      o_kd[1][j] = kv * (1.f + (ab - 1.f) * ka);
      o_gc[j] = acc[4][r];
      float kf = kv * pick4(kkc, j);
      kkf[r] = kf; aF[r] = af; aB[r] = ab;
      ssq += kf * kf;
      bon += rv * pick4(rkc, j) * (o_kd[0][j] + o_kd[1][j]);
    }
    size_t o = (size_t)m * 512 + c0;
    *reinterpret_cast<uint2*>(P.rr + o) = pack4(sh[0][0], sh[0][1], sh[0][2], sh[0][3]);
    *reinterpret_cast<uint2*>(P.rv + o) = pack4(sh[2][0], sh[2][1], sh[2][2], sh[2][3]);
    *reinterpret_cast<uint2*>(P.rgc + o) = pack4(o_gc[0], o_gc[1], o_gc[2], o_gc[3]);
#pragma unroll
    for (int d = 0; d < 2; ++d) {
      size_t od = (size_t)d * NTOK * 512 + o;
      *reinterpret_cast<float4*>(P.rdec + od) = make_float4(o_dec[d][0], o_dec[d][1], o_dec[d][2], o_dec[d][3]);
      *reinterpret_cast<uint2*>(P.rkd + od) = pack4(o_kd[d][0], o_kd[d][1], o_kd[d][2], o_kd[d][3]);
    }
  }
  ssq += __shfl_xor(ssq, 32, 64);
  bon += __shfl_xor(bon, 32, 64);
  if (hh == 0) { red[tl * 2 + chh] = ssq; red[(32 + tl) * 2 + chh] = bon; }
  __syncthreads();
  const float ssq_t = red[tl * 2] + red[tl * 2 + 1];
  const float bon_t = red[(32 + tl) * 2] + red[(32 + tl) * 2 + 1];
  const float rn = rsqrtf(ssq_t + 1e-12f);
#pragma unroll
  for (int g4 = 0; g4 < 4; ++g4) {
    const int c0 = hq * 64 + chh * 32 + 8 * g4 + 4 * hh;
    size_t o = (size_t)m * 512 + c0;
    float kk[4];
#pragma unroll
    for (int j = 0; j < 4; ++j) kk[j] = kkf[4 * g4 + j] * rn;
    *reinterpret_cast<uint2*>(P.rnkk + o) = pack4(-kk[0], -kk[1], -kk[2], -kk[3]);
    *reinterpret_cast<uint2*>(P.rbk + o) =
        pack4(kk[0] * aF[4 * g4], kk[1] * aF[4 * g4 + 1], kk[2] * aF[4 * g4 + 2], kk[3] * aF[4 * g4 + 3]);
    *reinterpret_cast<uint2*>(P.rbk + (size_t)NTOK * 512 + o) =
        pack4(kk[0] * aB[4 * g4], kk[1] * aB[4 * g4 + 1], kk[2] * aB[4 * g4 + 2], kk[3] * aB[4 * g4 + 3]);
  }
  if (chh == 0 && hh == 0) P.rbon[(size_t)m * 8 + hq] = bon_t;
}

__device__ __forceinline__ void attn_item(const Params& P, int layer, int it) {
  int lane = ltid() & 63, wave = ltid() >> 6;
  int nkeys, qtok, head;
  const u16 *kb, *vt;
  if (it < 128) {
    int b = it >> 6, qb = it & 7; head = (it >> 3) & 7;
    int kvh = head >> 2;
    nkeys = 1280;
    qtok = NCTX + b * 1024 + qb * 128;
    size_t hb = ((size_t)(layer * 2 + b) * 2 + kvh);
    kb = P.klat + hb * 1280 * 64;
    vt = P.vtlat + hb * 64 * 1280;
  } else {
    int j = it - 128;
    int b = j >> 4, qb = j & 1; head = (j >> 1) & 7;
    int kvh = head >> 2;
    nkeys = 256;
    qtok = b * 256 + qb * 128;
    kb = P.kctx + (size_t)(b * 2 + kvh) * 256 * 64;
    vt = P.vtctx + (size_t)(b * 2 + kvh) * 64 * 256;
  }
  int q0 = qtok + wave * 32;
  int r31 = lane & 31, hh = lane >> 5;
  bf16x8 qf[4];
  {
    const u16* qp = P.qbuf + (size_t)(q0 + r31) * 512 + head * 64 + hh * 8;
#pragma unroll
    for (int ks = 0; ks < 4; ++ks) qf[ks] = ld8(qp + ks * 16);
  }
  f32x16 o[2];
  o[0] = zero16(); o[1] = zero16();
  float mrun = -1e30f, lrun = 0.f;
  for (int kt = 0; kt < nkeys; kt += 64) {
    f32x16 x[2];
#pragma unroll
    for (int sub = 0; sub < 2; ++sub) {
      x[sub] = zero16();
      const u16* kp = kb + (size_t)(kt + sub * 32 + r31) * 64 + hh * 8;
#pragma unroll
      for (int ks = 0; ks < 4; ++ks) x[sub] = mfma(ld8(kp + ks * 16), qf[ks], x[sub]);
    }
    float mx = -1e30f;
#pragma unroll
    for (int sub = 0; sub < 2; ++sub)
#pragma unroll
      for (int r = 0; r < 16; ++r) mx = fmaxf(mx, x[sub][r]);
    mx = fmaxf(mx, __shfl_xor(mx, 32, 64));
    float mnew = fmaxf(mrun, mx * 0.125f);
    float alpha = __expf(mrun - mnew);
    mrun = mnew;
    float psum = 0.f;
    bf16x8 pf[2][2];
#pragma unroll
    for (int sub = 0; sub < 2; ++sub)
#pragma unroll
      for (int r = 0; r < 16; ++r) {
        float pv = __expf(x[sub][r] * 0.125f - mnew);
        psum += pv;
        pf[sub][r >> 3][r & 7] = (short)f2bf(pv);
      }
    lrun = lrun * alpha + psum;
#pragma unroll
    for (int dt = 0; dt < 2; ++dt) {
#pragma unroll
      for (int r = 0; r < 16; ++r) o[dt][r] *= alpha;
      const u16* vp = vt + (size_t)(dt * 32 + r31) * nkeys + kt + 4 * hh;
#pragma unroll
      for (int sub = 0; sub < 2; ++sub)
#pragma unroll
        for (int s = 0; s < 2; ++s) {
          bf16x8 vf = ld4x2(vp + sub * 32 + 16 * s, vp + sub * 32 + 16 * s + 8);
          o[dt] = mfma(vf, pf[sub][s], o[dt]);
        }
    }
  }
  lrun += __shfl_xor(lrun, 32, 64);
  float inv = __builtin_amdgcn_rcpf(lrun);
  u16* op = P.ocat + (size_t)(q0 + r31) * 1536 + head * 64;
#pragma unroll
  for (int dt = 0; dt < 2; ++dt)
#pragma unroll
    for (int g = 0; g < 4; ++g) {
      int d = dt * 32 + 8 * g + 4 * hh;
      uint2 w;
      w.x = pack2(o[dt][4 * g + 0] * inv, o[dt][4 * g + 1] * inv);
      w.y = pack2(o[dt][4 * g + 2] * inv, o[dt][4 * g + 3] * inv);
      *reinterpret_cast<uint2*>(op + d) = w;
    }
}

__device__ __forceinline__ void gla_scan_item(const Params& P, int layer, int it) {
  int lane = ltid() & 63, wave = ltid() >> 6;
  int s, h, dir;
  if (it < 16) { s = 16 + (it >> 3); h = (it >> 1) & 3; dir = it & 1; }
  else { int j = it - 16; s = j >> 3; h = (j >> 1) & 3; dir = j & 1; }
  int sbase, T;
  seq_info(s, sbase, T);
  const int nch = T >> 6;
  const int r31 = lane & 31, hh = lane >> 5;
  const int dv = wave * 32 + r31;
  f32x16 S[2];
  if (s >= 16) {
    const float* sp = P.in[I_SG] + ((((size_t)(s - 16) * 4 + layer) * 2 + dir) * 4 + h) * 64 * 128;
#pragma unroll
    for (int d2 = 0; d2 < 2; ++d2)
#pragma unroll
      for (int r = 0; r < 16; ++r) S[d2][r] = sp[(size_t)(d2 * 32 + accrow(r, hh)) * 128 + dv];
  } else { S[0] = zero16(); S[1] = zero16(); }
  const u16* qeb = P.gqe + (size_t)dir * NTOK * 256 + h * 64;
  u16* obi = P.obi + (size_t)dir * NTOK * 512 + h * 128 + dv;
  bf16x8 qf[2][2][2];
  auto load_q = [&](int cs, bf16x8 (&q)[2][2][2]) {
    int ctok = dir ? nch - 1 - cs : cs;
    int m0 = sbase + ctok * 64;
#pragma unroll
    for (int tt = 0; tt < 2; ++tt) {
      int i = tt * 32 + r31;
      int tok = m0 + (dir ? 63 - i : i);
#pragma unroll
      for (int d2 = 0; d2 < 2; ++d2)
#pragma unroll
        for (int sx = 0; sx < 2; ++sx) {
          const u16* qp = qeb + (size_t)tok * 256 + d2 * 32 + 16 * sx + 4 * hh;
          q[tt][d2][sx] = ld4x2(qp, qp + 8);
        }
    }
  };
#pragma unroll 1
  for (int cs = 0; cs < nch; ++cs) {
    load_q(cs, qf);
    const int ctok = dir ? nch - 1 - cs : cs;
    const int m0 = sbase + ctok * 64;
    const int gchunk = m0 >> 6;
    const float* gu = P.gU + ((((size_t)dir * 96 + gchunk) * 4 + h) * 128 + dv) * 64 + 4 * hh;
    const float* dl = P.gdl + ((size_t)dir * 96 + gchunk) * 256 + h * 64 + 4 * hh;
    float4 U[2][4];
    float4 dlv[2][4];
#pragma unroll
    for (int d2 = 0; d2 < 2; ++d2)
#pragma unroll
      for (int g = 0; g < 4; ++g) {
        U[d2][g] = *reinterpret_cast<const float4*>(gu + d2 * 32 + 8 * g);
        dlv[d2][g] = *reinterpret_cast<const float4*>(dl + d2 * 32 + 8 * g);
      }
#pragma unroll
    for (int tt = 0; tt < 2; ++tt) {
      f32x16 O = zero16();
#pragma unroll
      for (int d2 = 0; d2 < 2; ++d2)
#pragma unroll
        for (int sx = 0; sx < 2; ++sx) O = mfma(qf[tt][d2][sx], acc2frag(S[d2], sx), O);
      {
        const int i0 = tt * 32 + 4 * hh;
        u16* po = obi + (size_t)(m0 + (dir ? 63 - i0 : i0)) * 512;
        const long step = dir ? -512 : 512;
#pragma unroll
        for (int g = 0; g < 4; ++g) {
          po[(8 * g + 0) * step] = f2bf(O[4 * g + 0]);
          po[(8 * g + 1) * step] = f2bf(O[4 * g + 1]);
          po[(8 * g + 2) * step] = f2bf(O[4 * g + 2]);
          po[(8 * g + 3) * step] = f2bf(O[4 * g + 3]);
          __builtin_amdgcn_sched_barrier(0);
        }
      }
    }
#pragma unroll
    for (int d2 = 0; d2 < 2; ++d2)
#pragma unroll
      for (int g = 0; g < 4; ++g) {
        S[d2][4 * g + 0] = S[d2][4 * g + 0] * dlv[d2][g].x + U[d2][g].x;
        S[d2][4 * g + 1] = S[d2][4 * g + 1] * dlv[d2][g].y + U[d2][g].y;
        S[d2][4 * g + 2] = S[d2][4 * g + 2] * dlv[d2][g].z + U[d2][g].z;
        S[d2][4 * g + 3] = S[d2][4 * g + 3] * dlv[d2][g].w + U[d2][g].w;
      }
  }
  if (s < 16) {
    float* sp = P.out + O_SG + ((((size_t)s * 4 + layer) * 2 + dir) * 4 + h) * 64 * 128;
#pragma unroll
    for (int d2 = 0; d2 < 2; ++d2)
#pragma unroll
      for (int r = 0; r < 16; ++r) sp[(size_t)(d2 * 32 + accrow(r, hh)) * 128 + dv] = S[d2][r];
  }
}

template <int CTRL, int RS>
__device__ __forceinline__ void dpp_stage(float (&x)[RS]) {
#pragma unroll
  for (int i = 0; i < RS; ++i) x[i] = dpp_addf<CTRL>(x[i]);
}
template <int RS>
__device__ __forceinline__ void rwkv_scan_item(const Params& P, int layer, int s, int h, int dir, int rb, char* smem) {
  constexpr int NR = 16 * RS;
  int tid = ltid(), lane = tid & 63, wave = tid >> 6;
  int sbase, T;
  seq_info(s, sbase, T);
  if (s >= 16) __builtin_amdgcn_s_setprio(3);
  const int lrow = wave * 4 + (lane >> 4);
  const int c0 = (lane & 15) * 4;
  float4 S[RS];
#pragma unroll
  for (int rs = 0; rs < RS; ++rs) {
    S[rs] = make_float4(0.f, 0.f, 0.f, 0.f);
    if (s >= 16)
      S[rs] = *reinterpret_cast<const float4*>(P.in[I_SR] + (((((size_t)(s - 16) * 4 + layer) * 2 + dir) * 8 + h) * 64 + rb * NR + rs * 16 + lrow) * 64 + c0);
  }
  constexpr int BUF = 5 * 1024 + 2 * 16 * NR;
  float* buf = (float*)smem;
  const int lst = tid >> 4, lc4 = (tid & 15) * 4;
  const u16* gR = P.rr + h * 64;
  const float* gW = P.rdec + (size_t)dir * NTOK * 512 + h * 64;
  const u16* gK = P.rkd + (size_t)dir * NTOK * 512 + h * 64;
  const u16* gA = P.rnkk + h * 64;
  const u16* gB = P.rbk + (size_t)dir * NTOK * 512 + h * 64;
  const u16* gV = P.rv + h * 64 + rb * NR;
  float* yo = P.ry + (size_t)dir * NTOK * 512 + h * 64 + rb * NR;
  float4 pr, pw, pk, pa, pb; float pv[RS];
  __syncthreads();
  {
    int tok = sbase + (dir ? T - 1 - lst : lst);
    size_t o = (size_t)tok * 512;
    pr = unpack4(*reinterpret_cast<const uint2*>(gR + o + lc4));
    pw = *reinterpret_cast<const float4*>(gW + o + lc4);
    pk = unpack4(*reinterpret_cast<const uint2*>(gK + o + lc4));
    pa = unpack4(*reinterpret_cast<const uint2*>(gA + o + lc4));
    pb = unpack4(*reinterpret_cast<const uint2*>(gB + o + lc4));
#pragma unroll
    for (int q = 0; q < RS; ++q) {
      int idx = tid + q * NTHREADS, st = idx / NR, rr = idx % NR;
      int tk = sbase + (dir ? T - 1 - st : st);
      pv[q] = bf2f(gV[(size_t)tk * 512 + rr]);
    }
    float* bw = buf;
    *reinterpret_cast<float4*>(bw + 0 * 1024 + lst * 64 + lc4) = pr;
    *reinterpret_cast<float4*>(bw + 1 * 1024 + lst * 64 + lc4) = pw;
    *reinterpret_cast<float4*>(bw + 2 * 1024 + lst * 64 + lc4) = pk;
    *reinterpret_cast<float4*>(bw + 3 * 1024 + lst * 64 + lc4) = pa;
    *reinterpret_cast<float4*>(bw + 4 * 1024 + lst * 64 + lc4) = pb;
#pragma unroll
    for (int q = 0; q < RS; ++q) bw[5 * 1024 + tid + q * NTHREADS] = pv[q];
  }
  __syncthreads();
  const int nch = T >> 4;
#pragma unroll 1
  for (int ch = 0; ch < nch; ++ch) {
    const int cur = ch & 1;
    if (ch + 1 < nch) {
      int si = (ch + 1) * 16 + lst;
      int tok = sbase + (dir ? T - 1 - si : si);
      size_t o = (size_t)tok * 512;
      pr = unpack4(*reinterpret_cast<const uint2*>(gR + o + lc4));
      pw = *reinterpret_cast<const float4*>(gW + o + lc4);
      pk = unpack4(*reinterpret_cast<const uint2*>(gK + o + lc4));
      pa = unpack4(*reinterpret_cast<const uint2*>(gA + o + lc4));
      pb = unpack4(*reinterpret_cast<const uint2*>(gB + o + lc4));
#pragma unroll
      for (int q = 0; q < RS; ++q) {
        int idx = tid + q * NTHREADS, st = idx / NR, rr = idx % NR;
        int s2 = (ch + 1) * 16 + st;
        int tk = sbase + (dir ? T - 1 - s2 : s2);
        pv[q] = bf2f(gV[(size_t)tk * 512 + rr]);
      }
    }
    float* bb = buf + cur * BUF;
    float4 r4 = *reinterpret_cast<const float4*>(bb + 0 * 1024 + c0);
    float4 w4 = *reinterpret_cast<const float4*>(bb + 1 * 1024 + c0);
    float4 k4 = *reinterpret_cast<const float4*>(bb + 2 * 1024 + c0);
    float4 a4 = *reinterpret_cast<const float4*>(bb + 3 * 1024 + c0);
    float4 b4 = *reinterpret_cast<const float4*>(bb + 4 * 1024 + c0);
    float vv[RS];
#pragma unroll
    for (int rs = 0; rs < RS; ++rs) vv[rs] = bb[5 * 1024 + rs * 16 + lrow];
#pragma unroll
    for (int st = 0; st < 16; ++st) {
      float4 nr4, nw4, nk4, na4, nb4; float nvv[RS];
      if (st + 1 < 16) {
        nr4 = *reinterpret_cast<const float4*>(bb + 0 * 1024 + (st + 1) * 64 + c0);
        nw4 = *reinterpret_cast<const float4*>(bb + 1 * 1024 + (st + 1) * 64 + c0);
        nk4 = *reinterpret_cast<const float4*>(bb + 2 * 1024 + (st + 1) * 64 + c0);
        na4 = *reinterpret_cast<const float4*>(bb + 3 * 1024 + (st + 1) * 64 + c0);
        nb4 = *reinterpret_cast<const float4*>(bb + 4 * 1024 + (st + 1) * 64 + c0);
#pragma unroll
        for (int rs = 0; rs < RS; ++rs) nvv[rs] = bb[5 * 1024 + (st + 1) * NR + rs * 16 + lrow];
      }
      float sa[RS], y[RS];
#pragma unroll
      for (int rs = 0; rs < RS; ++rs) sa[rs] = (S[rs].x * a4.x + S[rs].y * a4.y) + (S[rs].z * a4.z + S[rs].w * a4.w);
      dpp_stage<0xB1, RS>(sa); dpp_stage<0x4E, RS>(sa); dpp_stage<0x141, RS>(sa); dpp_stage<0x140, RS>(sa);
#pragma unroll
      for (int rs = 0; rs < RS; ++rs) {
        S[rs].x = S[rs].x * w4.x + (sa[rs] * b4.x + vv[rs] * k4.x);
        S[rs].y = S[rs].y * w4.y + (sa[rs] * b4.y + vv[rs] * k4.y);
        S[rs].z = S[rs].z * w4.z + (sa[rs] * b4.z + vv[rs] * k4.z);
        S[rs].w = S[rs].w * w4.w + (sa[rs] * b4.w + vv[rs] * k4.w);
        y[rs] = (S[rs].x * r4.x + S[rs].y * r4.y) + (S[rs].z * r4.z + S[rs].w * r4.w);
      }
      dpp_stage<0xB1, RS>(y); dpp_stage<0x4E, RS>(y); dpp_stage<0x141, RS>(y); dpp_stage<0x140, RS>(y);
      if ((lane & 15) == 0) {
#pragma unroll
        for (int rs = 0; rs < RS; ++rs) bb[5 * 1024 + 16 * NR + st * NR + rs * 16 + lrow] = y[rs];
      }
      if (st + 1 < 16) {
        r4 = nr4; w4 = nw4; k4 = nk4; a4 = na4; b4 = nb4;
#pragma unroll
        for (int rs = 0; rs < RS; ++rs) vv[rs] = nvv[rs];
      }
    }
    if (ch + 1 < nch) {
      float* bw = buf + (cur ^ 1) * BUF;
      *reinterpret_cast<float4*>(bw + 0 * 1024 + lst * 64 + lc4) = pr;
      *reinterpret_cast<float4*>(bw + 1 * 1024 + lst * 64 + lc4) = pw;
      *reinterpret_cast<float4*>(bw + 2 * 1024 + lst * 64 + lc4) = pk;
      *reinterpret_cast<float4*>(bw + 3 * 1024 + lst * 64 + lc4) = pa;
      *reinterpret_cast<float4*>(bw + 4 * 1024 + lst * 64 + lc4) = pb;
#pragma unroll
      for (int q = 0; q < RS; ++q) bw[5 * 1024 + tid + q * NTHREADS] = pv[q];
    }
    __syncthreads();
#pragma unroll
    for (int q = 0; q < RS; ++q) {
      int idx = tid + q * NTHREADS, st = idx / NR, rr = idx % NR;
      int si = ch * 16 + st;
      int tok = sbase + (dir ? T - 1 - si : si);
      yo[(size_t)tok * 512 + rr] = bb[5 * 1024 + 16 * NR + idx];
    }
  }
  if (s < 16) {
#pragma unroll
    for (int rs = 0; rs < RS; ++rs)
      *reinterpret_cast<float4*>(P.out + O_SR + (((((size_t)s * 4 + layer) * 2 + dir) * 8 + h) * 64 + rb * NR + rs * 16 + lrow) * 64 + c0) = S[rs];
  }
  if (s >= 16) __builtin_amdgcn_s_setprio(0);
}

typedef float f2_t __attribute__((ext_vector_type(2)));
__device__ __forceinline__ void rwkv_scan_lat(const Params& P, int layer, int it, char* smem) {
  const int tid = ltid(), lane = tid & 63, wave = tid >> 6;
  const int s = 16 + (it >> 6), h = (it >> 3) & 7, dir = (it >> 2) & 1, rb = it & 3;
  int sbase, T;
  seq_info(s, sbase, T);
  __builtin_amdgcn_s_setprio(3);
  const int lrow = wave * 4 + (lane >> 4);
  const int row = rb * 16 + lrow;
  const int l15 = lane & 15;
  const int c0 = l15 * 4;
  f2_t S01, S23;
  {
    float4 s4 = *reinterpret_cast<const float4*>(P.in[I_SR] + (((((size_t)(s - 16) * 4 + layer) * 2 + dir) * 8 + h) * 64 + row) * 64 + c0);
    S01 = (f2_t){s4.x, s4.y}; S23 = (f2_t){s4.z, s4.w};
  }
  constexpr int BUF = 5 * 1024 + 256;
  float* buf = (float*)smem;
  float* ypart = buf + 2 * BUF;
  const int lst = tid >> 4, lc4 = (tid & 15) * 4, lrr = tid & 15;
  const u16* gR = P.rr + h * 64;
  const float* gW = P.rdec + (size_t)dir * NTOK * 512 + h * 64;
  const u16* gK = P.rkd + (size_t)dir * NTOK * 512 + h * 64;
  const u16* gA = P.rnkk + h * 64;
  const u16* gB = P.rbk + (size_t)dir * NTOK * 512 + h * 64;
  const u16* gV = P.rv + h * 64 + rb * 16;
  float* yo = P.ry + (size_t)dir * NTOK * 512 + h * 64 + rb * 16;
  float4 pr, pw, pk, pa, pb; float pv;
  __syncthreads();
  {
    int tok = sbase + (dir ? T - 1 - lst : lst);
    size_t o = (size_t)tok * 512;
    pr = unpack4(*reinterpret_cast<const uint2*>(gR + o + lc4));
    pw = *reinterpret_cast<const float4*>(gW + o + lc4);
    pk = unpack4(*reinterpret_cast<const uint2*>(gK + o + lc4));
    pa = unpack4(*reinterpret_cast<const uint2*>(gA + o + lc4));
    pb = unpack4(*reinterpret_cast<const uint2*>(gB + o + lc4));
    pv = bf2f(gV[o + lrr]);
    float* bw = buf;
    *reinterpret_cast<float4*>(bw + 0 * 1024 + lst * 64 + lc4) = pr;
    *reinterpret_cast<float4*>(bw + 1 * 1024 + lst * 64 + lc4) = pw;
    *reinterpret_cast<float4*>(bw + 2 * 1024 + lst * 64 + lc4) = pk;
    *reinterpret_cast<float4*>(bw + 3 * 1024 + lst * 64 + lc4) = pa;
    *reinterpret_cast<float4*>(bw + 4 * 1024 + lst * 64 + lc4) = pb;
    bw[5 * 1024 + tid] = pv;
  }
  __syncthreads();
  const int nch = T >> 4;
#pragma unroll 1
  for (int ch = 0; ch < nch; ++ch) {
    const int cur = ch & 1;
    if (ch + 1 < nch) {
      int si = (ch + 1) * 16 + lst;
      int tok = sbase + (dir ? T - 1 - si : si);
      size_t o = (size_t)tok * 512;
      pr = unpack4(*reinterpret_cast<const uint2*>(gR + o + lc4));
      pw = *reinterpret_cast<const float4*>(gW + o + lc4);
      pk = unpack4(*reinterpret_cast<const uint2*>(gK + o + lc4));
      pa = unpack4(*reinterpret_cast<const uint2*>(gA + o + lc4));
      pb = unpack4(*reinterpret_cast<const uint2*>(gB + o + lc4));
      pv = bf2f(gV[o + lrr]);
    }
    const float* bb = buf + cur * BUF;
    float4 Rr[4], Rw[4], Rk[4], Ra[4], Rb[4]; float Rv[4];
#pragma unroll
    for (int q = 0; q < 3; ++q) {
      Rr[q] = *reinterpret_cast<const float4*>(bb + 0 * 1024 + q * 64 + c0);
      Rw[q] = *reinterpret_cast<const float4*>(bb + 1 * 1024 + q * 64 + c0);
      Rk[q] = *reinterpret_cast<const float4*>(bb + 2 * 1024 + q * 64 + c0);
      Ra[q] = *reinterpret_cast<const float4*>(bb + 3 * 1024 + q * 64 + c0);
      Rb[q] = *reinterpret_cast<const float4*>(bb + 4 * 1024 + q * 64 + c0);
      Rv[q] = bb[5 * 1024 + q * 16 + lrow];
    }
#pragma unroll
    for (int st = 0; st < 16; ++st) {
      if (st + 3 < 16) {
        const int q = (st + 3) & 3;
        Rr[q] = *reinterpret_cast<const float4*>(bb + 0 * 1024 + (st + 3) * 64 + c0);
        Rw[q] = *reinterpret_cast<const float4*>(bb + 1 * 1024 + (st + 3) * 64 + c0);
        Rk[q] = *reinterpret_cast<const float4*>(bb + 2 * 1024 + (st + 3) * 64 + c0);
        Ra[q] = *reinterpret_cast<const float4*>(bb + 3 * 1024 + (st + 3) * 64 + c0);
        Rb[q] = *reinterpret_cast<const float4*>(bb + 4 * 1024 + (st + 3) * 64 + c0);
        Rv[q] = bb[5 * 1024 + (st + 3) * 16 + lrow];
      }
      const float4 r4 = Rr[st & 3], w4 = Rw[st & 3], k4 = Rk[st & 3], a4 = Ra[st & 3], b4 = Rb[st & 3];
      const float vv = Rv[st & 3];
      const f2_t a01 = {a4.x, a4.y}, a23 = {a4.z, a4.w}, b01 = {b4.x, b4.y}, b23 = {b4.z, b4.w};
      const f2_t k01 = {k4.x, k4.y}, k23 = {k4.z, k4.w}, w01 = {w4.x, w4.y}, w23 = {w4.z, w4.w};
      const f2_t r01 = {r4.x, r4.y}, r23 = {r4.z, r4.w};
      f2_t t = S01 * a01;
      t = __builtin_elementwise_fma(S23, a23, t);
      float sa = t.x + t.y;
      sa = dpp_addf<0xB1>(sa); sa = dpp_addf<0x4E>(sa); sa = dpp_addf<0x141>(sa); sa = dpp_addf<0x140>(sa);
      const f2_t sa2 = {sa, sa}, vv2 = {vv, vv};
      f2_t u01 = sa2 * b01, u23 = sa2 * b23;
      u01 = __builtin_elementwise_fma(vv2, k01, u01);
      u23 = __builtin_elementwise_fma(vv2, k23, u23);
      S01 = __builtin_elementwise_fma(S01, w01, u01);
      S23 = __builtin_elementwise_fma(S23, w23, u23);
      f2_t y2 = S01 * r01;
      y2 = __builtin_elementwise_fma(S23, r23, y2);
      ypart[(st * 16 + lrow) * 16 + l15] = y2.x + y2.y;
    }
    if (ch + 1 < nch) {
      float* bw = buf + (cur ^ 1) * BUF;
      *reinterpret_cast<float4*>(bw + 0 * 1024 + lst * 64 + lc4) = pr;
      *reinterpret_cast<float4*>(bw + 1 * 1024 + lst * 64 + lc4) = pw;
      *reinterpret_cast<float4*>(bw + 2 * 1024 + lst * 64 + lc4) = pk;
      *reinterpret_cast<float4*>(bw + 3 * 1024 + lst * 64 + lc4) = pa;
      *reinterpret_cast<float4*>(bw + 4 * 1024 + lst * 64 + lc4) = pb;
      bw[5 * 1024 + tid] = pv;
    }
    __syncthreads();
    {
      const float4* yp = reinterpret_cast<const float4*>(ypart + tid * 16);
      float4 q0 = yp[0], q1 = yp[1], q2 = yp[2], q3 = yp[3];
      float ys = ((q0.x + q0.y) + (q0.z + q0.w)) + ((q1.x + q1.y) + (q1.z + q1.w)) +
                 (((q2.x + q2.y) + (q2.z + q2.w)) + ((q3.x + q3.y) + (q3.z + q3.w)));
      int si = ch * 16 + lst;
      int tok = sbase + (dir ? T - 1 - si : si);
      yo[(size_t)tok * 512 + lrr] = ys;
    }
    __syncthreads();
  }
  __builtin_amdgcn_s_setprio(0);
}

__device__ __forceinline__ void post_item(const Params& P, int layer, int it) {
  int lane = ltid() & 63, wave = ltid() >> 6;
  int m = it * 4 + wave;
  {
    float va[8], vb[8], vc8[8], vd[8], v[8];
    unpack8(*reinterpret_cast<const uint4*>(P.ob + (size_t)m * 512 + lane * 8), va);
    unpack8(*reinterpret_cast<const uint4*>(P.ob + (size_t)(NTOK + m) * 512 + lane * 8), vb);
    unpack8(*reinterpret_cast<const uint4*>(P.obi + (size_t)m * 512 + lane * 8), vc8);
    unpack8(*reinterpret_cast<const uint4*>(P.obi + (size_t)(NTOK + m) * 512 + lane * 8), vd);
#pragma unroll
    for (int i = 0; i < 8; ++i) v[i] = (va[i] + vc8[i]) + (vb[i] + vd[i]);
    float ss = 0.f;
#pragma unroll
    for (int i = 0; i < 8; ++i) ss += v[i] * v[i];
    ss = group_sum<16>(ss);
    float rs = rsqrtf(ss * (1.f / 128.f) + 1e-6f);
    float gb[8];
    unpack8(*reinterpret_cast<const uint4*>(P.p + (size_t)m * LDP + OFF_GB + lane * 8), gb);
#pragma unroll
    for (int i = 0; i < 8; ++i) v[i] = v[i] * rs * P.in[I_GLAG][layer * 128 + (lane & 15) * 8 + i] * siluf_(gb[i]);
    *reinterpret_cast<uint4*>(P.ocat + (size_t)m * 1536 + 512 + lane * 8) = pack8(v);
  }
  {
    const float* a = P.ry + (size_t)m * 512 + lane * 8;
    const float* b = a + (size_t)NTOK * 512;
    float v[8];
    float4 a0 = *reinterpret_cast<const float4*>(a), a1 = *reinterpret_cast<const float4*>(a + 4);
    float4 b0 = *reinterpret_cast<const float4*>(b), b1 = *reinterpret_cast<const float4*>(b + 4);
    v[0] = a0.x + b0.x; v[1] = a0.y + b0.y; v[2] = a0.z + b0.z; v[3] = a0.w + b0.w;
    v[4] = a1.x + b1.x; v[5] = a1.y + b1.y; v[6] = a1.z + b1.z; v[7] = a1.w + b1.w;
    float sm = 0.f;
#pragma unroll
    for (int i = 0; i < 8; ++i) sm += v[i];
    sm = group_sum<8>(sm);
    float mean = sm * (1.f / 64.f);
    float vs = 0.f;
#pragma unroll
    for (int i = 0; i < 8; ++i) { float dd = v[i] - mean; vs += dd * dd; }
    vs = group_sum<8>(vs);
    float rs = rsqrtf(vs * (1.f / 64.f) + 64e-5f);
    float bon = P.rbon[(size_t)m * 8 + (lane >> 3)];
    int c = lane * 8;
    float vc[8], gc[8];
    unpack8(*reinterpret_cast<const uint4*>(P.rv + (size_t)m * 512 + c), vc);
    unpack8(*reinterpret_cast<const uint4*>(P.rgc + (size_t)m * 512 + c), gc);
#pragma unroll
    for (int i = 0; i < 8; ++i) {
      float gn = (v[i] - mean) * rs * P.in[I_LNW][layer * 512 + c + i] + P.in[I_LNB][layer * 512 + c + i];
      v[i] = (gn + bon * vc[i]) * gc[i];
    }
    *reinterpret_cast<uint4*>(P.ocat + (size_t)m * 1536 + 1024 + c) = pack8(v);
  }
}

#define XB_TMO      128
#define XB_XCNT(j)  (256  + 64 * (j))
#define XB_XSUB(j)  (1280 + 64 * (j))
#define XB_XGEN(j)  (2304 + 64 * (j))
#define XB_TOP      3328
#define XB_TOPGEN   3392
#define XCD_BAR_WORDS 3456
#define XB_SPIN_CAP (1u << 22)
__device__ __forceinline__ unsigned xb_ld(unsigned* p) { return __hip_atomic_load(p, __ATOMIC_RELAXED, __HIP_MEMORY_SCOPE_AGENT); }
__device__ __forceinline__ unsigned xb_add(unsigned* p, unsigned v) { return __hip_atomic_fetch_add(p, v, __ATOMIC_RELAXED, __HIP_MEMORY_SCOPE_AGENT); }
__device__ __forceinline__ unsigned xb_xcc_id() { return (unsigned)__builtin_amdgcn_s_getreg((3 << 11) | 20) & 0xFu; }
#define XB_SPIN(cond, bar) do { unsigned _sp = 0; while (cond) { __builtin_amdgcn_s_sleep(1); \
    if ((++_sp & 255u) == 0u) { if (xb_ld(&(bar)[XB_TMO])) break; if (_sp > XB_SPIN_CAP) { atomicAdd(&(bar)[XB_TMO], 1u); break; } } } } while (0)
struct XcdBarrier { unsigned* bar; unsigned x; unsigned nloc; unsigned nx; };
__device__ __forceinline__ XcdBarrier xcd_barrier_post(unsigned* bar) {
  XcdBarrier b; b.bar = bar; b.x = xb_xcc_id(); b.nloc = 0u; b.nx = 0u;
  if (threadIdx.x == 0) (void)xb_add(&bar[XB_XCNT(b.x)], 1u);
  return b;
}
__device__ __forceinline__ void xcd_barrier_complete(unsigned* bar, unsigned x, unsigned& nloc, unsigned& nx) {
  const unsigned G = gridDim.x;
  unsigned sum, cnt, mine, sp = 0u;
  for (;;) {
    sum = 0u; cnt = 0u; mine = 0u;
#pragma unroll
    for (unsigned j = 0; j < 16; ++j) { const unsigned c = xb_ld(&bar[XB_XCNT(j)]); sum += c; cnt += (c > 0u) ? 1u : 0u; mine = (j == x) ? c : mine; }
    if (sum == G) break;
    __builtin_amdgcn_s_sleep(1);
    if ((++sp & 255u) == 0u) { if (xb_ld(&bar[XB_TMO])) break; if (sp > XB_SPIN_CAP) { atomicAdd(&bar[XB_TMO], 1u); break; } }
  }
  nloc = mine > 0u ? mine : 1u; nx = cnt > 0u ? cnt : 1u;
}
__device__ __forceinline__ void xcd_barrier(XcdBarrier& b) {
  asm volatile("s_waitcnt vmcnt(0)" ::: "memory");
  __syncthreads();
  if (threadIdx.x == 0) {
    unsigned* bar = b.bar;
    __builtin_amdgcn_s_waitcnt(0);
    if (b.nloc == 0u) xcd_barrier_complete(bar, b.x, b.nloc, b.nx);
    const unsigned nloc = b.nloc, nx = b.nx;
    const unsigned old = xb_add(&bar[XB_XSUB(b.x)], 1u);
    const unsigned gen = old / nloc;
    if (old + 1u == (gen + 1u) * nloc) {
      __builtin_amdgcn_fence(__ATOMIC_RELEASE, "agent");
      asm volatile("s_waitcnt vmcnt(0)" ::: "memory");
      const unsigned og = xb_add(&bar[XB_TOP], 1u);
      const unsigned tg = og / nx;
      if (og + 1u == (tg + 1u) * nx) xb_add(&bar[XB_TOPGEN], 1u);
      else XB_SPIN(xb_ld(&bar[XB_TOPGEN]) == tg, bar);
      __builtin_amdgcn_fence(__ATOMIC_ACQUIRE, "agent");
      xb_add(&bar[XB_XGEN(b.x)], 1u);
      asm volatile("s_waitcnt vmcnt(0)" ::: "memory");
    } else {
      XB_SPIN(xb_ld(&bar[XB_XGEN(b.x)]) == gen, bar);
      __builtin_amdgcn_fence(__ATOMIC_ACQUIRE, "agent");
      asm volatile("s_waitcnt vmcnt(0)" ::: "memory");
    }
  }
  __syncthreads();
}

constexpr int N_PHASES = 1 + 10 * DEPTH;

__device__ __forceinline__ void run_phase(const Params& P, int layer, int sub, char* smem, int rep = 0) {
  const int G = gridDim.x, b = lbid();
  if (sub < 0) {
    const int total = 384 + CV_TOTAL + 1024;
    for (int it = b; it < total; it += G) {
      if (it < 384) adaln_item(P, it, smem);
      else if (it < 384 + CV_TOTAL) convert_item(P, 0, it - 384, smem);
      else cache_item(P, it - 384 - CV_TOTAL);
    }
    return;
  }
  switch (sub) {
    case 0: for (int it = b; it < NTOK / 4; it += G) norm_item(P, layer, 0, it); break;
    case 1: gemm_in_phase(P, layer, smem); break;
    case 2: {
      const int n1 = 768, n2 = 384, n3 = NTOK / 16;
      unsigned* ctr = P.bar + XCD_BAR_WORDS + rep * 512 + 256 + layer * 64;
      volatile int* sitem = (volatile int*)(smem + 65528);
      bool first = true;
      for (;;) {
        __syncthreads();
        if (threadIdx.x == 0) *sitem = first ? b : (int)(G + atomicAdd(ctr, 1u));
        __syncthreads();
        first = false;
        const int it = *sitem;
        if (it >= n1 + n2 + n3) break;
        if (it < n2) gla_prep_item(P, layer, it, smem);
        else if (it < n1 + n2) rwkv_prep_item(P, layer, it - n2, smem);
        else { for (int q = 0; q < 4; ++q) attn_prep_item(P, layer, (it - n1 - n2) * 4 + q); }
      }
    } break;
    case 3: {
      const int ncv = (layer + 1 < DEPTH) ? (CV_TOTAL + 1) / 2 : 0;
      const int total = 912 + ncv;
      unsigned* ctr = P.bar + XCD_BAR_WORDS + rep * 512 + layer * 64;
      volatile int* sitem = (volatile int*)(smem + 65528);
      bool first = true;
      for (;;) {
        __syncthreads();
        if (threadIdx.x == 0) *sitem = first ? b : (int)(G + atomicAdd(ctr, 1u));
        __syncthreads();
        first = false;
        const int it = *sitem;
        if (it >= total) break;
        if (it < 128) rwkv_scan_lat(P, layer, it, smem);
        else if (it < 144) { for (int q = 0; q < 1 + (PROBE_D == 2); ++q) gla_scan_item(P, layer, it - 128); }
        else if (it < 272) { for (int q = 0; q < 1 + (PROBE_D == 3); ++q) attn_item(P, layer, it - 144); }
        else if (it < 528) { int j = it - 272; rwkv_scan_item<4>(P, layer, j >> 4, (j >> 1) & 7, j & 1, 0, smem); }
        else if (it < 656) gla_scan_item(P, layer, it - 528 + 16);
        else if (it < 912) attn_item(P, layer, it - 656 + 128);
        else {
          const int c0 = (it - 912) * 2;
          for (int q = 0; q < 2; ++q)
            if (c0 + q < CV_TOTAL) convert_item(P, layer + 1, c0 + q, smem);
        }
      }
    } break;
    case 4: for (int it = b; it < NTOK / 4; it += G) post_item(P, layer, it); break;
    case 5: gemm_po_phase(P, layer, smem); break;
    case 6: gemm_res_phase(P, layer, 0, smem); break;
    case 7: for (int it = b; it < NTOK / 4; it += G) norm_item(P, layer, 1, it); break;
    case 8: gemm_ffi_phase(P, layer, smem); break;
    case 9: gemm_res_phase(P, layer, 1, smem); break;
  }
}

#if !MEGA
template <int SUB>
__global__ void __launch_bounds__(NTHREADS, 2) phase_kernel(Params P, int layer) {
  __shared__ __attribute__((aligned(16))) char smem[65536];
  run_phase(P, layer, SUB, smem);
}
#else
__global__ void __launch_bounds__(NTHREADS, 2) mega_kernel(Params P) {
  __shared__ __attribute__((aligned(16))) char smem[65536];
  cg::grid_group grid = cg::this_grid();
  if (P.out == nullptr) grid.sync();
  XcdBarrier xb = xcd_barrier_post(P.bar);
  for (int ph = 0; ph < N_PHASES; ++ph) {
    int layer = (ph == 0) ? 0 : (ph - 1) / 10;
    int sub = (ph == 0) ? -1 : (ph - 1) % 10;
    run_phase(P, layer, sub, smem);
    if (PROBE_DUP && sub >= 0 && ((PROBE_DUP >> sub) & 1)) { xcd_barrier(xb); run_phase(P, layer, sub, smem, 1); }
    if (ph + 1 < N_PHASES) { for (int q = 0; q < PROBE_SYNCN; ++q) xcd_barrier(xb); }
  }
}
#endif

extern "C" void kernel_launch(void* const* d_in, const int* in_sizes, int n_in, void* d_out, int out_size, void* d_ws,
                              size_t ws_size, hipStream_t stream) {
  Params P{};
  for (int i = 0; i < N_INPUTS; ++i) P.in[i] = (const float*)d_in[i];
  P.out = (float*)d_out;
  char* w = (char*)d_ws;
  size_t off = 0;
  auto alloc = [&](size_t bytes) { char* r = w + off; off += (bytes + 255) & ~(size_t)255; return r; };
  P.wb[0] = (u16*)alloc(WB_TOTAL * 2);
  P.wb[1] = (u16*)alloc(WB_TOTAL * 2);
  P.mod = (float*)alloc((size_t)4 * 3 * 6144 * 4);
  P.h = (u16*)alloc((size_t)NTOK * D * 2);
  P.p = (u16*)alloc((size_t)NTOK * LDP * 2);
  P.qbuf = (u16*)alloc((size_t)NTOK * 512 * 2);
  P.kctx = (u16*)alloc((size_t)16 * 2 * 256 * 64 * 2);
  P.vtctx = (u16*)alloc((size_t)16 * 2 * 64 * 256 * 2);
  P.klat = (u16*)alloc((size_t)4 * 2 * 2 * 1280 * 64 * 2);
  P.vtlat = (u16*)alloc((size_t)4 * 2 * 2 * 64 * 1280 * 2);
  P.gqe = (u16*)alloc((size_t)2 * NTOK * 256 * 2);
  P.gke = (u16*)alloc((size_t)2 * NTOK * 256 * 2);
  P.gklT = (u16*)alloc((size_t)2 * 96 * 4 * 64 * 64 * 2);
  P.gvT = (u16*)alloc((size_t)2 * 96 * 4 * 128 * 64 * 2);
  P.gdl = (float*)alloc((size_t)2 * 96 * 256 * 4);
  P.ob = (u16*)alloc((size_t)2 * NTOK * 512 * 2);
  P.obi = (u16*)alloc((size_t)2 * NTOK * 512 * 2);
  P.gU = (float*)alloc((size_t)2 * 96 * 4 * 64 * 128 * 4);
  P.rr = (u16*)alloc((size_t)NTOK * 512 * 2);
  P.rv = (u16*)alloc((size_t)NTOK * 512 * 2);
  P.rnkk = (u16*)alloc((size_t)NTOK * 512 * 2);
  P.rdec = (float*)alloc((size_t)2 * NTOK * 512 * 4);
  P.rkd = (u16*)alloc((size_t)2 * NTOK * 512 * 2);
  P.rbk = (u16*)alloc((size_t)2 * NTOK * 512 * 2);
  P.rgc = (u16*)alloc((size_t)NTOK * 512 * 2);
  P.rbon = (float*)alloc((size_t)NTOK * 8 * 4);
  P.ry = (float*)alloc((size_t)2 * NTOK * 512 * 4);
  P.ocat = (u16*)alloc((size_t)NTOK * 1536 * 2);
  P.bar = (unsigned*)alloc((size_t)(XCD_BAR_WORDS + 1024) * 4);
  if (off > ws_size) { fprintf(stderr, "workspace too small: need %zu have %zu\n", off, ws_size); return; }

  static int grid_blocks = 0;
  if (!grid_blocks) {
    int dev = 0, cus = 0, per_cu = 0;
    hipGetDevice(&dev);
    hipDeviceGetAttribute(&cus, hipDeviceAttributeMultiprocessorCount, dev);
#if MEGA
    hipOccupancyMaxActiveBlocksPerMultiprocessor(&per_cu, mega_kernel, NTHREADS, 0);
#else
    hipOccupancyMaxActiveBlocksPerMultiprocessor(&per_cu, phase_kernel<1>, NTHREADS, 0);
#endif
    if (per_cu < 1) per_cu = 1;
    if (per_cu > 2) per_cu = 2;
    grid_blocks = cus * per_cu;
  }
#if MEGA
  hipMemsetAsync(P.bar, 0, (size_t)(XCD_BAR_WORDS + 1024) * 4, stream);
  void* args[] = {&P};
  hipError_t e = hipLaunchCooperativeKernel((void*)mega_kernel, dim3(grid_blocks), dim3(NTHREADS), args, 0, stream);
  if (e != hipSuccess) fprintf(stderr, "cooperative launch failed: %s (grid %d)\n", hipGetErrorString(e), grid_blocks);
#else
  phase_kernel<-1><<<grid_blocks, NTHREADS, 0, stream>>>(P, 0);
  for (int l = 0; l < DEPTH; ++l) {
    for (int q = 0; q < 1 + ((PROBE_DUP >> 0) & 1); ++q) phase_kernel<0><<<grid_blocks, NTHREADS, 0, stream>>>(P, l);
    for (int q = 0; q < 1 + ((PROBE_DUP >> 1) & 1); ++q) phase_kernel<1><<<grid_blocks, NTHREADS, 0, stream>>>(P, l);
    for (int q = 0; q < 1 + ((PROBE_DUP >> 2) & 1); ++q) phase_kernel<2><<<grid_blocks, NTHREADS, 0, stream>>>(P, l);
    for (int q = 0; q < 1 + ((PROBE_DUP >> 3) & 1); ++q) phase_kernel<3><<<grid_blocks, NTHREADS, 0, stream>>>(P, l);
    for (int q = 0; q < 1 + ((PROBE_DUP >> 4) & 1); ++q) phase_kernel<4><<<grid_blocks, NTHREADS, 0, stream>>>(P, l);
    for (int q = 0; q < 1 + ((PROBE_DUP >> 5) & 1); ++q) phase_kernel<5><<<grid_blocks, NTHREADS, 0, stream>>>(P, l);
    for (int q = 0; q < 1 + ((PROBE_DUP >> 6) & 1); ++q) phase_kernel<6><<<grid_blocks, NTHREADS, 0, stream>>>(P, l);
    for (int q = 0; q < 1 + ((PROBE_DUP >> 7) & 1); ++q) phase_kernel<7><<<grid_blocks, NTHREADS, 0, stream>>>(P, l);
    for (int q = 0; q < 1 + ((PROBE_DUP >> 8) & 1); ++q) phase_kernel<8><<<grid_blocks, NTHREADS, 0, stream>>>(P, l);
    for (int q = 0; q < 1 + ((PROBE_DUP >> 9) & 1); ++q) phase_kernel<9><<<grid_blocks, NTHREADS, 0, stream>>>(P, l);
  }
#endif
}
```

```cpp
#include <hip/hip_runtime.h>
#include <hip/hip_cooperative_groups.h>
#include <stdint.h>
#include <cstdio>
namespace cg = cooperative_groups;

#ifndef PROBE_SYNCN
#define PROBE_SYNCN 1
#endif
#ifndef PROBE_C
#define PROBE_C 0
#endif
#ifndef PROBE_D
#define PROBE_D 0
#endif
#ifndef PROBE_DUP
#define PROBE_DUP 0
#endif
#ifndef MEGA
#define MEGA 1
#endif

typedef unsigned short u16;
typedef __attribute__((ext_vector_type(8))) short bf16x8;
typedef __attribute__((ext_vector_type(4))) short bf16x4;
typedef __attribute__((ext_vector_type(16))) float f32x16;

constexpr int D = 1024;
constexpr int NTOK = 6144;
constexpr int NCTX = 4096;
constexpr int DEPTH = 4;
constexpr int NIN = 7328;
constexpr int LDP = 7424;
constexpr int DFF = 2816;
constexpr int OFF_KA = 512, OFF_VA = 640, OFF_QB = 768, OFF_KB = 1024, OFF_VB = 1280, OFF_GB = 1792,
              OFF_GKF = 2304, OFF_GKB = 2320, OFF_C = 2336, OFF_GATE = 4256;
constexpr int NTHREADS = 256;

enum { I_XP = 0, I_XS, I_CK, I_CV, I_SG, I_SR, I_C, I_CCTX, I_WADA, I_BADA, I_GMIX, I_GFFN, I_WIN, I_QG, I_KG,
       I_GKW2, I_GKB, I_GLAG, I_MU, I_W0, I_W2, I_A0, I_A2, I_G2, I_KK, I_KA, I_RK, I_LNW, I_LNB,
       I_WPA, I_WPB, I_WPC, I_WOUT, I_WFI, I_WFO, N_INPUTS };

constexpr size_t O_YP = 0, O_YS = 4194304, O_CK = 6291456, O_CV = 8388608, O_SG = 10485760, O_SR = 14680064;

constexpr size_t WB_IN = 0;
constexpr size_t WB_PO = WB_IN + (size_t)LDP * 1024;
constexpr size_t WB_OUT = WB_PO + (size_t)3 * 1024 * 512;
constexpr size_t WB_FI = WB_OUT + (size_t)1024 * 1024;
constexpr size_t WB_FO = WB_FI + (size_t)5632 * 1024;
constexpr size_t WB_LORA = WB_FO + (size_t)1024 * 2816;
constexpr size_t WB_TOTAL = WB_LORA + (size_t)4 * 32768 + 65536;

struct Params {
  const float* in[N_INPUTS];
  float* out;
  u16* wb[2];
  float* mod;
  u16* h;
  u16* p;
  u16* qbuf;
  u16* kctx;
  u16* vtctx;
  u16* klat;
  u16* vtlat;
  u16* gqe;
  u16* gke;
  u16* gklT;
  u16* gvT;
  float* gdl;
  u16* ob;
  u16* obi;
  float* gU;
  u16* rr;
  u16* rv;
  u16* rnkk;
  float* rdec;
  u16* rkd;
  u16* rbk;
  u16* rgc;
  float* rbon;
  float* ry;
  u16* ocat;
  unsigned* bar;
};

__device__ __forceinline__ int ltid() { int t = threadIdx.x; asm volatile("" : "+v"(t)); return t; }
__device__ __forceinline__ int lbid() { int t = blockIdx.x; asm volatile("" : "+s"(t)); return t; }
__device__ __forceinline__ u16 f2bf(float f) {
  unsigned u = __float_as_uint(f);
  u += 0x7fffu + ((u >> 16) & 1u);
  return (u16)(u >> 16);
}
__device__ __forceinline__ float bf2f(u16 b) { return __uint_as_float(((unsigned)b) << 16); }
__device__ __forceinline__ unsigned pack2(float a, float b) { return (unsigned)f2bf(a) | ((unsigned)f2bf(b) << 16); }
__device__ __forceinline__ float sigmoidf_(float x) { return __builtin_amdgcn_rcpf(1.f + __expf(-x)); }
__device__ __forceinline__ float siluf_(float x) { return x * __builtin_amdgcn_rcpf(1.f + __expf(-x)); }
__device__ __forceinline__ float softplusf_(float x) { return fmaxf(x, 0.f) + log1pf(__expf(-fabsf(x))); }

template <int CTRL>
__device__ __forceinline__ float dpp_addf(float x) {
  int xi = __float_as_int(x);
  int yi = __builtin_amdgcn_update_dpp(0, xi, CTRL, 0xF, 0xF, true);
  return x + __int_as_float(yi);
}
template <int N>
__device__ __forceinline__ float group_sum(float x) {
  x = dpp_addf<0xB1>(x);
  x = dpp_addf<0x4E>(x);
  x = dpp_addf<0x141>(x);
  if (N >= 16) x = dpp_addf<0x140>(x);
  if (N >= 32) x += __shfl_xor(x, 16, 64);
  if (N >= 64) x += __shfl_xor(x, 32, 64);
  return x;
}

__device__ __forceinline__ void unpack8(uint4 r, float* v) {
  v[0] = __uint_as_float(r.x << 16); v[1] = __uint_as_float(r.x & 0xffff0000u);
  v[2] = __uint_as_float(r.y << 16); v[3] = __uint_as_float(r.y & 0xffff0000u);
  v[4] = __uint_as_float(r.z << 16); v[5] = __uint_as_float(r.z & 0xffff0000u);
  v[6] = __uint_as_float(r.w << 16); v[7] = __uint_as_float(r.w & 0xffff0000u);
}
__device__ __forceinline__ uint4 pack8(const float* v) {
  uint4 r; r.x = pack2(v[0], v[1]); r.y = pack2(v[2], v[3]); r.z = pack2(v[4], v[5]); r.w = pack2(v[6], v[7]);
  return r;
}
__device__ __forceinline__ float4 unpack4(uint2 r) {
  return make_float4(__uint_as_float(r.x << 16), __uint_as_float(r.x & 0xffff0000u), __uint_as_float(r.y << 16),
                     __uint_as_float(r.y & 0xffff0000u));
}
__device__ __forceinline__ uint2 pack4(float a, float b, float c, float d) { uint2 r; r.x = pack2(a, b); r.y = pack2(c, d); return r; }
__device__ __forceinline__ f32x16 zero16() {
  f32x16 z;
#pragma unroll
  for (int i = 0; i < 16; ++i) z[i] = 0.f;
  return z;
}
__device__ __forceinline__ f32x16 mfma(bf16x8 a, bf16x8 b, f32x16 c) {
  return __builtin_amdgcn_mfma_f32_32x32x16_bf16(a, b, c, 0, 0, 0);
}
__device__ __forceinline__ int accrow(int r, int h) { return (r & 3) + 8 * (r >> 2) + 4 * h; }

__device__ __forceinline__ bf16x8 ld8(const u16* p) { return *reinterpret_cast<const bf16x8*>(p); }
__device__ __forceinline__ bf16x8 ld4x2(const u16* p0, const u16* p1) {
  bf16x4 a = *reinterpret_cast<const bf16x4*>(p0);
  bf16x4 b = *reinterpret_cast<const bf16x4*>(p1);
  bf16x8 r;
  r[0] = a[0]; r[1] = a[1]; r[2] = a[2]; r[3] = a[3]; r[4] = b[0]; r[5] = b[1]; r[6] = b[2]; r[7] = b[3];
  return r;
}
__device__ __forceinline__ bf16x8 acc2frag(const f32x16& x, int s) {
  bf16x8 r;
#pragma unroll
  for (int j = 0; j < 8; ++j) r[j] = (short)f2bf(x[8 * s + j]);
  return r;
}

__device__ __forceinline__ void seq_info(int s, int& base, int& T) {
  if (s < 16) { base = s * 256; T = 256; } else { base = NCTX + (s - 16) * 1024; T = 1024; }
}
__device__ __forceinline__ int cond_of(int m) { return m < NCTX ? 0 : 1 + ((m - NCTX) >> 10); }

__device__ __forceinline__ void convert_tile(const float* __restrict__ src, int Nsrc, u16* __restrict__ dst, int K, int kt, int nt,
                             int kind, char* smem) {
  float* tile = (float*)smem;
  int tid = ltid();
  __syncthreads();
#pragma unroll
  for (int pss = 0; pss < 4; ++pss) {
    int kr = pss * 16 + (tid >> 4);
    int nl = (tid & 15) * 4;
    int scol;
    if (kind == 5) scol = (nl < 32) ? (32 * nt + nl) : (DFF + 32 * nt + nl - 32);
    else scol = nt * 64 + nl;
    float4 v = make_float4(0.f, 0.f, 0.f, 0.f);
    if (scol < Nsrc) v = *reinterpret_cast<const float4*>(src + (size_t)(kt * 64 + kr) * Nsrc + scol);
    tile[kr * 65 + nl + 0] = v.x; tile[kr * 65 + nl + 1] = v.y; tile[kr * 65 + nl + 2] = v.z; tile[kr * 65 + nl + 3] = v.w;
  }
  __syncthreads();
  int n = tid >> 2, ks = (tid & 3) * 16;
  float v[16];
#pragma unroll
  for (int i = 0; i < 16; ++i) v[i] = tile[(ks + i) * 65 + n];
  u16* dp = dst + (size_t)(nt * 64 + n) * K + kt * 64 + ks;
  *reinterpret_cast<uint4*>(dp) = pack8(v);
  *reinterpret_cast<uint4*>(dp + 8) = pack8(v + 8);
}
constexpr int CV_IN = 16 * 116, CV_PO = 8 * 16, CV_OUT = 16 * 16, CV_FI = 16 * 88, CV_FO = 44 * 16;
constexpr int CV_LORA = 4 * 8 + 16;
constexpr int CV_TOTAL = CV_IN + 3 * CV_PO + CV_OUT + CV_FI + CV_FO + CV_LORA;
__device__ __forceinline__ void convert_item(const Params& P, int layer, int it, char* smem) {
  u16* wb = P.wb[layer & 1];
  if (it < CV_IN) { convert_tile(P.in[I_WIN] + (size_t)layer * 1024 * NIN, NIN, wb + WB_IN, 1024, it % 16, it / 16, 0, smem); return; }
  it -= CV_IN;
  if (it < 3 * CV_PO) {
    int w = it / CV_PO, r = it % CV_PO;
    convert_tile(P.in[I_WPA + w] + (size_t)layer * 512 * 1024, 1024, wb + WB_PO + (size_t)w * 1024 * 512, 512, r % 8, r / 8, 1 + w, smem);
    return;
  }
  it -= 3 * CV_PO;
  if (it < CV_OUT) { convert_tile(P.in[I_WOUT] + (size_t)layer * 1024 * 1024, 1024, wb + WB_OUT, 1024, it % 16, it / 16, 4, smem); return; }
  it -= CV_OUT;
  if (it < CV_FI) { convert_tile(P.in[I_WFI] + (size_t)layer * 1024 * 5632, 5632, wb + WB_FI, 1024, it % 16, it / 16, 5, smem); return; }
  it -= CV_FI;
  if (it < CV_FO) { convert_tile(P.in[I_WFO] + (size_t)layer * DFF * 1024, 1024, wb + WB_FO, DFF, it % 44, it / 44, 6, smem); return; }
  it -= CV_FO;
  if (it < 32) {
    int mtx = it >> 3, nt = it & 7;
    const float* src = P.in[(mtx < 2) ? I_W2 : I_A2] + (size_t)(layer * 2 + (mtx & 1)) * 64 * 512;
    convert_tile(src, 512, wb + WB_LORA + (size_t)mtx * 32768, 64, 0, nt, 7, smem);
    return;
  }
  it -= 32;
  convert_tile(P.in[I_G2] + (size_t)layer * 128 * 512, 512, wb + WB_LORA + (size_t)4 * 32768, 128, it & 1, it >> 1, 8, smem);
}

__device__ __forceinline__ void adaln_item(const Params& P, int it, char* smem) {
  int layer = it / 96, nb = it % 96;
  float* sc = (float*)smem;
  float* red = sc + 3072;
  int tid = ltid();
  __syncthreads();
  for (int e = tid; e < 3072; e += NTHREADS) {
    int c = e >> 10, k = e & 1023;
    float v = (c == 0) ? P.in[I_CCTX][k] : P.in[I_C][(c - 1) * 1024 + k];
    sc[e] = siluf_(v);
  }
  __syncthreads();
  int cg4 = (tid & 15) * 4, ks = tid >> 4;
  float acc[3][4];
#pragma unroll
  for (int c = 0; c < 3; ++c)
#pragma unroll
    for (int j = 0; j < 4; ++j) acc[c][j] = 0.f;
  const float* w = P.in[I_WADA] + (size_t)layer * 1024 * 6144 + nb * 64 + cg4;
#pragma unroll 4
  for (int i = 0; i < 64; ++i) {
    int k = i * 16 + ks;
    float4 wv = *reinterpret_cast<const float4*>(w + (size_t)k * 6144);
#pragma unroll
    for (int c = 0; c < 3; ++c) {
      float s = sc[c * 1024 + k];
      acc[c][0] += s * wv.x; acc[c][1] += s * wv.y; acc[c][2] += s * wv.z; acc[c][3] += s * wv.w;
    }
  }
#pragma unroll
  for (int c = 0; c < 3; ++c)
#pragma unroll
    for (int j = 0; j < 4; ++j) red[(ks * 3 + c) * 64 + cg4 + j] = acc[c][j];
  __syncthreads();
  if (tid < 192) {
    int c = tid >> 6, col = tid & 63;
    float s = P.in[I_BADA][layer * 6144 + nb * 64 + col];
#pragma unroll
    for (int k2 = 0; k2 < 16; ++k2) s += red[(k2 * 3 + c) * 64 + col];
    P.mod[((size_t)layer * 3 + c) * 6144 + nb * 64 + col] = s;
  }
}

__device__ __forceinline__ void cache_item(const Params& P, int it) {
  int e = it * NTHREADS + ltid();
  int d = e & 63, kvh = (e >> 6) & 1, key = (e >> 7) & 255, l = (e >> 15) & 3, b = e >> 17;
  float kv = P.in[I_CK][e], vv = P.in[I_CV][e];
  size_t hb = ((size_t)(l * 2 + b) * 2 + kvh);
  P.klat[(hb * 1280 + key) * 64 + d] = f2bf(kv);
  P.vtlat[(hb * 64 + d) * 1280 + key] = f2bf(vv);
}

__device__ __forceinline__ void norm_item(const Params& P, int layer, int which, int it) {
  int lane = ltid() & 63, wave = ltid() >> 6;
  int m = it * 4 + wave;
  const float* xrow;
  if (which == 0 && layer == 0) xrow = (m < NCTX) ? P.in[I_XP] + (size_t)m * D : P.in[I_XS] + (size_t)(m - NCTX) * D;
  else xrow = P.out + (size_t)m * D;
  const float* g = P.in[which ? I_GFFN : I_GMIX] + layer * D;
  const float* md = P.mod + ((size_t)layer * 3 + cond_of(m)) * 6144 + (which ? 3 * D : 0);
  float4 xv[4];
  float ss = 0.f;
#pragma unroll
  for (int i = 0; i < 4; ++i) {
    xv[i] = *reinterpret_cast<const float4*>(xrow + i * 256 + lane * 4);
    ss += xv[i].x * xv[i].x + xv[i].y * xv[i].y + xv[i].z * xv[i].z + xv[i].w * xv[i].w;
  }
  ss = group_sum<64>(ss);
  float rs = rsqrtf(ss * (1.f / 1024.f) + 1e-6f);
#pragma unroll
  for (int i = 0; i < 4; ++i) {
    int c = i * 256 + lane * 4;
    float4 gv = *reinterpret_cast<const float4*>(g + c);
    float4 sh = *reinterpret_cast<const float4*>(md + c);
    float4 scv = *reinterpret_cast<const float4*>(md + D + c);
    float a0 = xv[i].x * rs * gv.x * (1.f + scv.x) + sh.x;
    float a1 = xv[i].y * rs * gv.y * (1.f + scv.y) + sh.y;
    float a2 = xv[i].z * rs * gv.z * (1.f + scv.z) + sh.z;
    float a3 = xv[i].w * rs * gv.w * (1.f + scv.w) + sh.w;
    uint2 o; o.x = pack2(a0, a1); o.y = pack2(a2, a3);
    *reinterpret_cast<uint2*>(P.h + (size_t)m * D + c) = o;
  }
}

__device__ __forceinline__ void glds16(const u16* g, char* l) {
  __builtin_amdgcn_global_load_lds((const unsigned*)g, (__attribute__((address_space(3))) unsigned*)l, 16, 0, 0);
}
template <int BM, int BN, int WM, int WN>
__device__ __forceinline__ void gemm_core(const u16* __restrict__ A, int lda, const u16* __restrict__ B, int ldb, int K,
                                          int m0, int n0, char* smem, f32x16 (&acc)[BM / (32 * WM)][BN / (32 * WN)]) {
  constexpr int NA = BM / 32;
  constexpr int NB = BN / 32;
  constexpr int MI = BM / (32 * WM), NI = BN / (32 * WN);
  const u16* sA = (const u16*)smem;
  const u16* sB = sA + 2 * 128 * 64;
  const int tid = ltid(), lane = tid & 63, wave = tid >> 6;
  const int wm = wave / WN, wn = wave % WN;
  const int lr = tid >> 3, lc = tid & 7;
  const u16* Ap = A + (size_t)(m0 + lr) * lda + ((lc ^ (lr & 7)) << 3);
  const u16* Bp = B + (size_t)(n0 + lr) * ldb + ((lc ^ (lr & 7)) << 3);
  char* lA = smem + tid * 16;
  char* lB = smem + 32768 + tid * 16;
  const int nk = K >> 6;
  __syncthreads();
#pragma unroll
  for (int i = 0; i < NA; ++i) glds16(Ap + (size_t)i * 32 * lda, lA + i * 4096);
#pragma unroll
  for (int i = 0; i < NB; ++i) glds16(Bp + (size_t)i * 32 * ldb, lB + i * 4096);
  asm volatile("s_waitcnt vmcnt(0)" ::: "memory");
  __syncthreads();
  const int r31 = lane & 31, hh = lane >> 5;
  for (int kt = 0; kt < nk; ++kt) {
    const int cur = kt & 1;
    if (kt + 1 < nk) {
#pragma unroll
      for (int i = 0; i < NA; ++i) glds16(Ap + (size_t)i * 32 * lda + (kt + 1) * 64, lA + (cur ^ 1) * (BM * 128) + i * 4096);
#pragma unroll
      for (int i = 0; i < NB; ++i) glds16(Bp + (size_t)i * 32 * ldb + (kt + 1) * 64, lB + (cur ^ 1) * (BN * 128) + i * 4096);
    }
    const u16* cA = sA + cur * BM * 64;
    const u16* cB = sB + cur * BN * 64;
    bf16x8 af[2][MI], bfr[2][NI];
#pragma unroll
    for (int mi = 0; mi < MI; ++mi) {
      int row = wm * (BM / WM) + mi * 32 + r31;
      af[0][mi] = ld8(cA + row * 64 + ((hh ^ (row & 7)) << 3));
    }
#pragma unroll
    for (int ni = 0; ni < NI; ++ni) {
      int row = wn * (BN / WN) + ni * 32 + r31;
      bfr[0][ni] = ld8(cB + row * 64 + ((hh ^ (row & 7)) << 3));
    }
#pragma unroll
    for (int ks = 0; ks < 4; ++ks) {
      if (ks + 1 < 4) {
#pragma unroll
        for (int mi = 0; mi < MI; ++mi) {
          int row = wm * (BM / WM) + mi * 32 + r31;
          af[(ks + 1) & 1][mi] = ld8(cA + row * 64 + ((((ks + 1) * 2 + hh) ^ (row & 7)) << 3));
        }
#pragma unroll
        for (int ni = 0; ni < NI; ++ni) {
          int row = wn * (BN / WN) + ni * 32 + r31;
          bfr[(ks + 1) & 1][ni] = ld8(cB + row * 64 + ((((ks + 1) * 2 + hh) ^ (row & 7)) << 3));
        }
      }
#pragma unroll
      for (int mi = 0; mi < MI; ++mi)
#pragma unroll
        for (int ni = 0; ni < NI; ++ni) acc[mi][ni] = mfma(af[ks & 1][mi], bfr[ks & 1][ni], acc[mi][ni]);
    }
    asm volatile("s_waitcnt vmcnt(0)" ::: "memory");
    __syncthreads();
  }
}

__device__ __forceinline__ bool tile_coords(int iter, int mt, int nt, int& tm, int& tn) {
  int G = gridDim.x, b = lbid();
  int t;
  if ((G & 7) == 0) {
    int nloc = G >> 3;
    t = ((iter * 8 + (b & 7)) * nloc) + (b >> 3);
  } else {
    t = iter * G + b;
  }
  int total = mt * nt;
  if (t >= total) return false;
  int full = nt >> 3;
  int fullTiles = full * mt * 8;
  if (t < fullTiles) {
    int band = t / (mt * 8), rem = t % (mt * 8);
    int g = rem >> 6, i = rem & 63;
    tm = g * 8 + (i & 7);
    tn = band * 8 + (i >> 3);
  } else {
    int rem = t - fullTiles;
    tm = rem % mt;
    tn = full * 8 + rem / mt;
  }
  return true;
}
__device__ __forceinline__ int tile_iters(int mt, int nt) {
  int G = gridDim.x;
  int total = mt * nt;
  if ((G & 7) == 0) {
    int nloc = G >> 3;
    int chunks = (total + nloc - 1) / nloc;
    return (chunks + 7) / 8;
  }
  return (total + G - 1) / G;
}

__device__ __forceinline__ void gemm_in_phase(const Params& P, int layer, char* smem) {
  const u16* W = P.wb[layer & 1] + WB_IN;
  const int mt = NTOK / 128, nt = LDP / 128;
  const int lane = ltid() & 63, wave = ltid() >> 6, wm = wave >> 1, wn = wave & 1;
  int iters = tile_iters(mt, nt);
  for (int it = 0; it < iters; ++it) {
    int tm, tn;
    if (!tile_coords(it, mt, nt, tm, tn)) continue;
    f32x16 acc[2][2];
#pragma unroll
    for (int a = 0; a < 2; ++a)
#pragma unroll
      for (int b = 0; b < 2; ++b) acc[a][b] = zero16();
    gemm_core<128, 128, 2, 2>(P.h, D, W, D, D, tm * 128, tn * 128, smem, acc);
#pragma unroll
    for (int mi = 0; mi < 2; ++mi)
#pragma unroll
      for (int ni = 0; ni < 2; ++ni)
#pragma unroll
        for (int r = 0; r < 16; ++r) {
          int row = tm * 128 + wm * 64 + mi * 32 + accrow(r, lane >> 5);
          int col = tn * 128 + wn * 64 + ni * 32 + (lane & 31);
          P.p[(size_t)row * LDP + col] = f2bf(acc[mi][ni][r]);
        }
  }
}

__device__ __forceinline__ void gemm_po_phase(const Params& P, int layer, char* smem) {
  const u16* W = P.wb[layer & 1] + WB_PO;
  const int mt = NTOK / 96, nt = D / 128;
  const int lane = ltid() & 63, wave = ltid() >> 6;
  int iters = tile_iters(mt, nt);
  for (int it = 0; it < iters; ++it) {
    int tm, tn;
    if (!tile_coords(it, mt, nt, tm, tn)) continue;
    f32x16 tot[3];
    tot[0] = zero16(); tot[1] = zero16(); tot[2] = zero16();
    const int col = tn * 128 + wave * 32 + (lane & 31);
    for (int br = 0; br < 3; ++br) {
      f32x16 acc[3][1];
      acc[0][0] = zero16(); acc[1][0] = zero16(); acc[2][0] = zero16();
      gemm_core<96, 128, 1, 4>(P.ocat + br * 512, 1536, W + (size_t)br * 1024 * 512, 512, 512, tm * 96, tn * 128, smem, acc);
      const u16* gp = P.p + (size_t)(tm * 96 + 4 * (lane >> 5)) * LDP + OFF_GATE + br * D + col;
#pragma unroll
      for (int mi = 0; mi < 3; ++mi) {
#pragma unroll
        for (int q = 0; q < 4; ++q) {
          const u16* gq = gp + (size_t)(mi * 32 + 8 * q) * LDP;
          float g0 = sigmoidf_(bf2f(gq[0])), g1 = sigmoidf_(bf2f(gq[LDP])), g2 = sigmoidf_(bf2f(gq[2 * LDP])),
                g3 = sigmoidf_(bf2f(gq[3 * LDP]));
          tot[mi][4 * q + 0] += g0 * acc[mi][0][4 * q + 0];
          tot[mi][4 * q + 1] += g1 * acc[mi][0][4 * q + 1];
          tot[mi][4 * q + 2] += g2 * acc[mi][0][4 * q + 2];
          tot[mi][4 * q + 3] += g3 * acc[mi][0][4 * q + 3];
          __builtin_amdgcn_sched_barrier(0);
        }
      }
    }
#pragma unroll
    for (int mi = 0; mi < 3; ++mi)
#pragma unroll
      for (int r = 0; r < 16; ++r) {
        int row = tm * 96 + mi * 32 + accrow(r, lane >> 5);
        P.h[(size_t)row * D + col] = f2bf(tot[mi][r]);
      }
  }
}

__device__ __forceinline__ void gemm_res_phase(const Params& P, int layer, int which, char* smem) {
  const u16* A; const u16* W; int K, lda;
  if (which == 0) { A = P.h; lda = D; W = P.wb[layer & 1] + WB_OUT; K = D; }
  else { A = P.p; lda = DFF; W = P.wb[layer & 1] + WB_FO; K = DFF; }
  const int mt = NTOK / 96, nt = D / 128;
  const int lane = ltid() & 63, wave = ltid() >> 6;
  int iters = tile_iters(mt, nt);
  for (int it = 0; it < iters; ++it) {
    int tm, tn;
    if (!tile_coords(it, mt, nt, tm, tn)) continue;
    f32x16 acc[3][1];
    acc[0][0] = zero16(); acc[1][0] = zero16(); acc[2][0] = zero16();
    gemm_core<96, 128, 1, 4>(A, lda, W, K, K, tm * 96, tn * 128, smem, acc);
    const int col = tn * 128 + wave * 32 + (lane & 31);
#pragma unroll
    for (int mi = 0; mi < 3; ++mi)
#pragma unroll
      for (int r = 0; r < 16; ++r) {
        int row = tm * 96 + mi * 32 + accrow(r, lane >> 5);
        const float* xin;
        if (which == 0 && layer == 0) xin = (row < NCTX) ? P.in[I_XP] + (size_t)row * D : P.in[I_XS] + (size_t)(row - NCTX) * D;
        else xin = P.out + (size_t)row * D;
        float gt = P.mod[((size_t)layer * 3 + cond_of(row)) * 6144 + (which ? 5 * D : 2 * D) + col];
        P.out[(size_t)row * D + col] = xin[col] + gt * acc[mi][0][r];
      }
  }
}

__device__ __forceinline__ void gemm_ffi_phase(const Params& P, int layer, char* smem) {
  const u16* W = P.wb[layer & 1] + WB_FI;
  const int mt = NTOK / 128, nt = 5632 / 128;
  const int lane = ltid() & 63, wave = ltid() >> 6, wm = wave >> 1, wn = wave & 1;
  u16* act = P.p;
  int iters = tile_iters(mt, nt);
  for (int it = 0; it < iters; ++it) {
    int tm, tn;
    if (!tile_coords(it, mt, nt, tm, tn)) continue;
    f32x16 acc[2][2];
#pragma unroll
    for (int a = 0; a < 2; ++a)
#pragma unroll
      for (int b = 0; b < 2; ++b) acc[a][b] = zero16();
    gemm_core<128, 128, 2, 2>(P.h, D, W, D, D, tm * 128, tn * 128, smem, acc);
    int j = tn * 2 + wn;
#pragma unroll
    for (int mi = 0; mi < 2; ++mi)
#pragma unroll
      for (int r = 0; r < 16; ++r) {
        int row = tm * 128 + wm * 64 + mi * 32 + accrow(r, lane >> 5);
        int col = j * 32 + (lane & 31);
        act[(size_t)row * DFF + col] = f2bf(siluf_(acc[mi][0][r]) * acc[mi][1][r]);
      }
  }
}

__device__ __forceinline__ void rope8(float* v, int d0, int t) {
  float row = (float)(t >> 6), col = (float)(t & 63);
#pragma unroll
  for (int i = 0; i < 4; ++i) {
    int pi = (d0 >> 1) + i;
    float pos = (pi < 16) ? row : col;
    float inv = exp2f(-(float)(pi & 15) * (13.287712379549449f / 16.f));
    float ang = pos * inv;
    float n = rintf(ang * 0.15915494309189535f);
    float rr = fmaf(-n, 6.2831855f, ang);
    rr = fmaf(-n, -1.7484555e-7f, rr);
    float sn = __sinf(rr), cs = __cosf(rr);
    float x0 = v[2 * i], x1 = v[2 * i + 1];
    v[2 * i] = x0 * cs - x1 * sn;
    v[2 * i + 1] = x0 * sn + x1 * cs;
  }
}

__device__ __forceinline__ void attn_prep_item(const Params& P, int layer, int it) {
  int lane = ltid() & 63, wave = ltid() >> 6;
  int m = it * 4 + wave;
  const u16* prow = P.p + (size_t)m * LDP;
  bool lat = m >= NCTX;
  int b, t;
  if (!lat) { b = m >> 8; t = m & 255; } else { b = (m - NCTX) >> 10; t = (m - NCTX) & 1023; }
  {
    float v[8];
    unpack8(*reinterpret_cast<const uint4*>(prow + lane * 8), v);
    float ss = 0.f;
#pragma unroll
    for (int i = 0; i < 8; ++i) ss += v[i] * v[i];
    ss = group_sum<8>(ss);
    float rs = rsqrtf(ss * (1.f / 64.f) + 1e-6f);
    int d0 = (lane & 7) * 8;
#pragma unroll
    for (int i = 0; i < 8; ++i) v[i] = v[i] * rs * P.in[I_QG][layer * 64 + d0 + i];
    if (lat) rope8(v, d0, t);
    *reinterpret_cast<uint4*>(P.qbuf + (size_t)m * 512 + lane * 8) = pack8(v);
  }
  {
    int l2 = lane & 31;
    float v[8];
    unpack8(*reinterpret_cast<const uint4*>(prow + OFF_KA + l2 * 8), v);
    float ss = 0.f;
#pragma unroll
    for (int i = 0; i < 8; ++i) ss += v[i] * v[i];
    ss = group_sum<8>(ss);
    int d0 = (l2 & 7) * 8;
    int kvh = (l2 >> 3) & 1;
    if (l2 < 16) {
      float rs = rsqrtf(ss * (1.f / 64.f) + 1e-6f);
#pragma unroll
      for (int i = 0; i < 8; ++i) v[i] = v[i] * rs * P.in[I_KG][layer * 64 + d0 + i];
      if (!lat) {
        if (lane < 32) {
          float* ok = P.out + O_CK + (((size_t)(b * 4 + layer) * 256 + t) * 2 + kvh) * 64 + d0;
          *reinterpret_cast<float4*>(ok) = make_float4(v[0], v[1], v[2], v[3]);
          *reinterpret_cast<float4*>(ok + 4) = make_float4(v[4], v[5], v[6], v[7]);
          *reinterpret_cast<uint4*>(P.kctx + (((size_t)(b * 2 + kvh)) * 256 + t) * 64 + d0) = pack8(v);
        }
      } else {
        rope8(v, d0, t);
        if (lane < 32)
          *reinterpret_cast<uint4*>(P.klat + ((((size_t)(layer * 2 + b)) * 2 + kvh) * 1280 + 256 + t) * 64 + d0) = pack8(v);
      }
    } else {
      if (lane < 32) {
        if (!lat) {
          float* ov = P.out + O_CV + (((size_t)(b * 4 + layer) * 256 + t) * 2 + kvh) * 64 + d0;
          *reinterpret_cast<float4*>(ov) = make_float4(v[0], v[1], v[2], v[3]);
          *reinterpret_cast<float4*>(ov + 4) = make_float4(v[4], v[5], v[6], v[7]);
          u16* vt = P.vtctx + ((size_t)(b * 2 + kvh) * 64 + d0) * 256 + t;
#pragma unroll
          for (int i = 0; i < 8; ++i) vt[i * 256] = f2bf(v[i]);
        } else {
          u16* vt = P.vtlat + ((((size_t)(layer * 2 + b)) * 2 + kvh) * 64 + d0) * 1280 + 256 + t;
#pragma unroll
          for (int i = 0; i < 8; ++i) vt[i * 1280] = f2bf(v[i]);
        }
      }
    }
  }
}

__device__ __forceinline__ void gla_prep_item(const Params& P, int layer, int it, char* smem) {
  int chunk = it >> 2, h = it & 3;
  int m0 = chunk * 64;
  int tid = ltid();
  float* bc = (float*)smem;
  u16* sq = (u16*)(smem + 32768);
  u16* sk = sq + 4096;
  u16* slr = sk + 4096;
  __syncthreads();
  {
    int row = tid >> 2, seg = (tid & 3) * 16;
    const u16* pr = P.p + (size_t)(m0 + row) * LDP;
    *reinterpret_cast<uint4*>(sq + row * 64 + seg) = *reinterpret_cast<const uint4*>(pr + OFF_QB + h * 64 + seg);
    *reinterpret_cast<uint4*>(sq + row * 64 + seg + 8) = *reinterpret_cast<const uint4*>(pr + OFF_QB + h * 64 + seg + 8);
    *reinterpret_cast<uint4*>(sk + row * 64 + seg) = *reinterpret_cast<const uint4*>(pr + OFF_KB + h * 64 + seg);
    *reinterpret_cast<uint4*>(sk + row * 64 + seg + 8) = *reinterpret_cast<const uint4*>(pr + OFF_KB + h * 64 + seg + 8);
    int part = tid & 3;
    *reinterpret_cast<uint4*>(slr + ((part >> 1) * 64 + row) * 16 + (part & 1) * 8) =
        *reinterpret_cast<const uint4*>(pr + OFF_GKF + part * 8);
  }
  __syncthreads();
  {
    int dk = tid & 63, tg = tid >> 6;
#pragma unroll
    for (int dir = 0; dir < 2; ++dir) {
      float w[16];
#pragma unroll
      for (int r = 0; r < 16; ++r) w[r] = P.in[I_GKW2][((size_t)(layer * 2 + dir) * 16 + r) * 256 + h * 64 + dk];
      float bias = P.in[I_GKB][(layer * 2 + dir) * 256 + h * 64 + dk];
      for (int tt = 0; tt < 16; ++tt) {
        int t = tg * 16 + tt;
        float z = bias;
#pragma unroll
        for (int r = 0; r < 16; ++r) z += bf2f(slr[(dir * 64 + t) * 16 + r]) * w[r];
        float ls = fminf(z, 0.f) - __logf(1.f + __expf(-fabsf(z)));
        bc[(dir * 64 + t) * 64 + dk] = ls * (1.f / 16.f);
      }
    }
  }
  __syncthreads();
  if (tid < 128) {
    int dk = tid & 63, dir = tid >> 6;
    float run = 0.f;
    if (dir == 0) { for (int t = 0; t < 64; ++t) { run += bc[t * 64 + dk]; bc[t * 64 + dk] = run; } }
    else { for (int t = 63; t >= 0; --t) { run += bc[(64 + t) * 64 + dk]; bc[(64 + t) * 64 + dk] = run; } }
  }
  __syncthreads();
  {
    int t = tid >> 2, seg = (tid & 3) * 16;
#pragma unroll
    for (int dir = 0; dir < 2; ++dir) {
      float qv[16], kv[16];
#pragma unroll
      for (int i = 0; i < 16; ++i) {
        float bb = bc[(dir * 64 + t) * 64 + seg + i];
        qv[i] = bf2f(sq[t * 64 + seg + i]) * 0.125f * __expf(bb);
        kv[i] = bf2f(sk[t * 64 + seg + i]) * __expf(-bb);
      }
      size_t o = ((size_t)dir * NTOK + m0 + t) * 256 + h * 64 + seg;
      *reinterpret_cast<uint4*>(P.gqe + o) = pack8(qv);
      *reinterpret_cast<uint4*>(P.gqe + o + 8) = pack8(qv + 8);
      *reinterpret_cast<uint4*>(P.gke + o) = pack8(kv);
      *reinterpret_cast<uint4*>(P.gke + o + 8) = pack8(kv + 8);
    }
  }
  {
    int dk = tid >> 2, iseg = (tid & 3) * 16;
#pragma unroll
    for (int dir = 0; dir < 2; ++dir) {
      float blast = bc[(dir * 64 + (dir ? 0 : 63)) * 64 + dk];
      float kv[16];
#pragma unroll
      for (int ii = 0; ii < 16; ++ii) {
        int i = iseg + ii;
        int t = dir ? 63 - i : i;
        kv[ii] = bf2f(sk[t * 64 + dk]) * __expf(blast - bc[(dir * 64 + t) * 64 + dk]);
      }
      size_t o = ((((size_t)dir * 96 + chunk) * 4 + h) * 64 + dk) * 64 + iseg;
      *reinterpret_cast<uint4*>(P.gklT + o) = pack8(kv);
      *reinterpret_cast<uint4*>(P.gklT + o + 8) = pack8(kv + 8);
      if ((tid & 3) == 0) P.gdl[((size_t)dir * 96 + chunk) * 256 + h * 64 + dk] = __expf(blast);
    }
  }
  {
    int dv = tid >> 1, iseg = (tid & 1) * 32;
#pragma unroll
    for (int dir = 0; dir < 2; ++dir) {
      size_t o = ((((size_t)dir * 96 + chunk) * 4 + h) * 128 + dv) * 64 + iseg;
#pragma unroll
      for (int g = 0; g < 4; ++g) {
        unsigned w[4];
#pragma unroll
        for (int q = 0; q < 4; ++q) {
          int i0 = iseg + g * 8 + q * 2;
          int t0 = dir ? 63 - i0 : i0, t1 = dir ? 63 - (i0 + 1) : i0 + 1;
          unsigned a = P.p[(size_t)(m0 + t0) * LDP + OFF_VB + h * 128 + dv];
          unsigned b2 = P.p[(size_t)(m0 + t1) * LDP + OFF_VB + h * 128 + dv];
          w[q] = a | (b2 << 16);
        }
        *reinterpret_cast<uint4*>(P.gvT + o + g * 8) = make_uint4(w[0], w[1], w[2], w[3]);
      }
    }
  }
  asm volatile("s_waitcnt vmcnt(0)" ::: "memory");
  __syncthreads();
  {
    const int lane = tid & 63, wave = tid >> 6;
    const int r31 = lane & 31, hh = lane >> 5;
    const int dv = wave * 32 + r31;
#pragma unroll 1
    for (int dir = 0; dir < 2; ++dir) {
      const u16* qeb = P.gqe + (size_t)dir * NTOK * 256 + h * 64;
      const u16* keb = P.gke + (size_t)dir * NTOK * 256 + h * 64;
      u16* ob = P.ob + (size_t)dir * NTOK * 512 + h * 128 + dv;
      const int tokA0 = m0 + (dir ? 63 - r31 : r31);
      const int tokA1 = m0 + (dir ? 31 - r31 : 32 + r31);
      const u16* vT = P.gvT + ((((size_t)dir * 96 + chunk) * 4 + h) * 128 + dv) * 64;
      const u16* klT = P.gklT + ((((size_t)dir * 96 + chunk) * 4 + h) * 64) * 64;
      f32x16 X00 = zero16(), X01 = zero16(), X11 = zero16();
#pragma unroll
      for (int ks = 0; ks < 4; ++ks) {
        bf16x8 k0 = ld8(keb + (size_t)tokA0 * 256 + ks * 16 + hh * 8);
        bf16x8 k1 = ld8(keb + (size_t)tokA1 * 256 + ks * 16 + hh * 8);
        bf16x8 q0 = ld8(qeb + (size_t)tokA0 * 256 + ks * 16 + hh * 8);
        bf16x8 q1 = ld8(qeb + (size_t)tokA1 * 256 + ks * 16 + hh * 8);
        X00 = mfma(k0, q0, X00);
        X01 = mfma(k0, q1, X01);
        X11 = mfma(k1, q1, X11);
      }
#pragma unroll
      for (int r = 0; r < 16; ++r) {
        bool keep = accrow(r, hh) <= r31;
        X00[r] = keep ? X00[r] : 0.f;
        X11[r] = keep ? X11[r] : 0.f;
      }
#pragma unroll 1
      for (int tt = 0; tt < 2; ++tt) {
        f32x16 O = zero16();
#pragma unroll
        for (int sx = 0; sx < 2; ++sx) {
          const u16* vp = vT + 16 * sx + 4 * hh;
          bf16x8 v0 = ld4x2(vp, vp + 8);
          if (tt == 0) {
            O = mfma(acc2frag(X00, sx), v0, O);
          } else {
            bf16x8 v1 = ld4x2(vp + 32, vp + 40);
            O = mfma(acc2frag(X01, sx), v0, O);
            O = mfma(acc2frag(X11, sx), v1, O);
          }
        }
#pragma unroll
        for (int r = 0; r < 16; ++r) {
          int i = tt * 32 + accrow(r, hh);
          int tok = m0 + (dir ? 63 - i : i);
          ob[(size_t)tok * 512] = f2bf(O[r]);
        }
      }
      float* gu = P.gU + ((((size_t)dir * 96 + chunk) * 4 + h) * 128 + dv) * 64 + 4 * hh;
#pragma unroll
      for (int d2 = 0; d2 < 2; ++d2) {
        f32x16 U = zero16();
#pragma unroll
        for (int ks = 0; ks < 4; ++ks) {
          bf16x8 a = ld8(klT + (size_t)(d2 * 32 + r31) * 64 + ks * 16 + hh * 8);
          bf16x8 b2 = ld8(vT + ks * 16 + hh * 8);
          U = mfma(a, b2, U);
        }
#pragma unroll
        for (int g = 0; g < 4; ++g)
          *reinterpret_cast<float4*>(gu + d2 * 32 + 8 * g) = make_float4(U[4 * g], U[4 * g + 1], U[4 * g + 2], U[4 * g + 3]);
      }
    }
  }
}

__device__ __forceinline__ float tanhf_(float x) { return 1.f - 2.f * __builtin_amdgcn_rcpf(__expf(2.f * x) + 1.f); }
__device__ __forceinline__ float pick4(const float4& v, int j) { return j == 0 ? v.x : (j == 1 ? v.y : (j == 2 ? v.z : v.w)); }
__device__ __forceinline__ void rwkv_prep_item(const Params& P, int layer, int it, char* smem) {
  const int tt = it >> 2, hp = it & 3;
  const int m0 = tt * 32;
  int sbase, T;
  { int s = m0 < NCTX ? (m0 >> 8) : 16 + ((m0 - NCTX) >> 10); seq_info(s, sbase, T); }
  const int tid = ltid(), lane = tid & 63, wave = tid >> 6;
  constexpr int LS = 392;
  u16* lin = (u16*)smem;
  const float* mu = P.in[I_MU] + layer * 1920;
  __syncthreads();
#pragma unroll 1
  for (int half = 0; half < 1; ++half) {
    uint4 lu[6], lp[6], ln[6];
    const uint4 z4 = make_uint4(0u, 0u, 0u, 0u);
#pragma unroll
    for (int q = 0; q < 6; ++q) {
      int g = tid + (half * 6 + q) * NTHREADS;
      int tk = g / 48, cg8 = g % 48;
      int m = m0 + tk, t = m - sbase;
      const u16* pr = P.p + (size_t)m * LDP + OFF_C + 1536 + cg8 * 8;
      lu[q] = *reinterpret_cast<const uint4*>(pr);
      lp[q] = (t > 0) ? *reinterpret_cast<const uint4*>(pr - LDP) : z4;
      ln[q] = (t < T - 1) ? *reinterpret_cast<const uint4*>(pr + LDP) : z4;
    }
#pragma unroll
    for (int q = 0; q < 6; ++q) {
      int g = tid + (half * 6 + q) * NTHREADS;
      int tk = g / 48, cg8 = g % 48;
      float u[8], pv[8], nx[8], o[8];
      unpack8(lu[q], u); unpack8(lp[q], pv); unpack8(ln[q], nx);
      float4 mu0 = *reinterpret_cast<const float4*>(mu + 1536 + cg8 * 8);
      float4 mu1 = *reinterpret_cast<const float4*>(mu + 1536 + cg8 * 8 + 4);
      float mus[8] = {mu0.x, mu0.y, mu0.z, mu0.w, mu1.x, mu1.y, mu1.z, mu1.w};
      const float sa_ = (cg8 < 16) ? 2.f : 1.f, sc_ = (cg8 < 16) ? -1.f : 0.f;
      const bool ident = (cg8 >= 16) && (cg8 < 32);
#pragma unroll
      for (int i = 0; i < 8; ++i) {
        float pc = u[i] + mus[i] * (0.5f * (pv[i] + nx[i]) - u[i]);
        float sg = __builtin_amdgcn_rcpf(1.f + __expf(-sa_ * pc));
        o[i] = ident ? pc : (sa_ * sg + sc_);
      }
      *reinterpret_cast<uint4*>(lin + tk * LS + cg8 * 8) = pack8(o);
    }
  }
  __syncthreads();
  const int hsub = wave >> 1, chh = wave & 1;
  const int hq = hp * 2 + hsub;
  const int r31 = lane & 31, hh = lane >> 5;
  f32x16 acc[5];
#pragma unroll
  for (int q = 0; q < 5; ++q) acc[q] = zero16();
  {
    const u16* wl = P.wb[layer & 1] + WB_LORA;
    const int cw = hq * 64 + chh * 32 + r31;
    const u16* lrow = lin + r31 * LS + hh * 8;
#pragma unroll
    for (int q = 0; q < 4; ++q)
#pragma unroll
      for (int ks = 0; ks < 4; ++ks)
        acc[q] = mfma(ld8(wl + (size_t)q * 32768 + cw * 64 + ks * 16 + hh * 8), ld8(lrow + q * 64 + ks * 16), acc[q]);
#pragma unroll
    for (int ks = 0; ks < 8; ++ks)
      acc[4] = mfma(ld8(wl + (size_t)4 * 32768 + cw * 128 + ks * 16 + hh * 8), ld8(lrow + 256 + ks * 16), acc[4]);
  }
  __syncthreads();
  u16* raw = (u16*)smem + hsub * 6528;
  float* red = (float*)(smem + 32768) + hsub * 128;
  {
    uint4 sv[7];
#pragma unroll
    for (int q = 0; q < 7; ++q) {
      int g = tid + q * NTHREADS;
      int hs = g / 816, g2 = g % 816;
      int part = (g2 >> 3) % 3, rr = g2 / 24, chunk = g2 & 7;
      int m = m0 - 1 + rr, t = m - sbase;
      sv[q] = make_uint4(0u, 0u, 0u, 0u);
      if (g < 2 * 34 * 24 && t >= 0 && t < T)
        sv[q] = *reinterpret_cast<const uint4*>(P.p + (size_t)m * LDP + OFF_C + part * 512 + (hp * 2 + hs) * 64 + chunk * 8);
    }
#pragma unroll
    for (int q = 0; q < 7; ++q) {
      int g = tid + q * NTHREADS;
      int hs = g / 816, g2 = g % 816;
      int part = (g2 >> 3) % 3, rr = g2 / 24, chunk = g2 & 7;
      if (g < 2 * 34 * 24) *reinterpret_cast<uint4*>((u16*)smem + hs * 6528 + (rr * 3 + part) * 64 + chunk * 8) = sv[q];
    }
  }
  __syncthreads();
  const int tl = r31;
  const int m = m0 + tl;
  float kkf[16], aF[16], aB[16];
  float ssq = 0.f, bon = 0.f;
#pragma unroll
  for (int g4 = 0; g4 < 4; ++g4) {
    const int cl0 = chh * 32 + 8 * g4 + 4 * hh;
    const int c0 = hq * 64 + cl0;
    const float4 w0f = *reinterpret_cast<const float4*>(P.in[I_W0] + (layer * 2 + 0) * 512 + c0);
    const float4 w0b = *reinterpret_cast<const float4*>(P.in[I_W0] + (layer * 2 + 1) * 512 + c0);
    const float4 a0f = *reinterpret_cast<const float4*>(P.in[I_A0] + (layer * 2 + 0) * 512 + c0);
    const float4 a0b = *reinterpret_cast<const float4*>(P.in[I_A0] + (layer * 2 + 1) * 512 + c0);
    const float4 kkc = *reinterpret_cast<const float4*>(P.in[I_KK] + layer * 512 + c0);
    const float4 kac = *reinterpret_cast<const float4*>(P.in[I_KA] + layer * 512 + c0);
    const float4 rkc = *reinterpret_cast<const float4*>(P.in[I_RK] + layer * 512 + c0);
    const float4 mur = *reinterpret_cast<const float4*>(mu + c0);
    const float4 muk = *reinterpret_cast<const float4*>(mu + 512 + c0);
    const float4 muv = *reinterpret_cast<const float4*>(mu + 1024 + c0);
    float sh[3][4];
#pragma unroll
    for (int part = 0; part < 3; ++part) {
      uint2 pu = *reinterpret_cast<const uint2*>(raw + ((tl + 0) * 3 + part) * 64 + cl0);
      uint2 cu = *reinterpret_cast<const uint2*>(raw + ((tl + 1) * 3 + part) * 64 + cl0);
      uint2 nu = *reinterpret_cast<const uint2*>(raw + ((tl + 2) * 3 + part) * 64 + cl0);
      unsigned pw[2] = {pu.x, pu.y}, cw2[2] = {cu.x, cu.y}, nw[2] = {nu.x, nu.y};
#pragma unroll
      for (int j = 0; j < 4; ++j) {
        float uu = bf2f((u16)(cw2[j >> 1] >> (16 * (j & 1))));
        float pp = bf2f((u16)(pw[j >> 1] >> (16 * (j & 1))));
        float nn = bf2f((u16)(nw[j >> 1] >> (16 * (j & 1))));
        float muj = pick4(part == 0 ? mur : (part == 1 ? muk : muv), j);
        sh[part][j] = uu + muj * (0.5f * (pp + nn) - uu);
      }
    }
    float o_dec[2][4], o_kd[2][4], o_gc[4];
#pragma unroll
    for (int j = 0; j < 4; ++j) {
      const int r = 4 * g4 + j;
      float rv = sh[0][j], kv = sh[1][j];
      float af = sigmoidf_(pick4(a0f, j) + acc[2][r]);
      float ab = sigmoidf_(pick4(a0b, j) + acc[3][r]);
      float wlf = pick4(w0f, j) + acc[0][r];
      float wlb = pick4(w0b, j) + acc[1][r];
      o_dec[0][j] = __expf(-0.6065306597126334f * sigmoidf_(wlf));
      o_dec[1][j] = __expf(-0.6065306597126334f * sigmoidf_(wlb));
      float ka = pick4(kac, j);
      o_kd[0][j] = kv * (1.f + (af - 1.f) * ka);
      o_kd[1][j] = kv * (1.f + (ab - 1.f) * ka);
      o_gc[j] = acc[4][r];
      float kf = kv * pick4(kkc, j);
      kkf[r] = kf; aF[r] = af; aB[r] = ab;
      ssq += kf * kf;
      bon += rv * pick4(rkc, j) * (o_kd[0][j] + o_kd[1][j]);
    }
    size_t o = (size_t)m * 512 + c0;
    *reinterpret_cast<uint2*>(P.rr + o) = pack4(sh[0][0], sh[0][1], sh[0][2], sh[0][3]);
    *reinterpret_cast<uint2*>(P.rv + o) = pack4(sh[2][0], sh[2][1], sh[2][2], sh[2][3]);
    *reinterpret_cast<uint2*>(P.rgc + o) = pack4(o_gc[0], o_gc[1], o_gc[2], o_gc[3]);
#pragma unroll
    for (int d = 0; d < 2; ++d) {
      size_t od = (size_t)d * NTOK * 512 + o;
      *reinterpret_cast<float4*>(P.rdec + od) = make_float4(o_dec[d][0], o_dec[d][1], o_dec[d][2], o_dec[d][3]);
      *reinterpret_cast<uint2*>(P.rkd + od) = pack4(o_kd[d][0], o_kd[d][1], o_kd[d][2], o_kd[d][3]);
    }
  }
  ssq += __shfl_xor(ssq, 32, 64);
  bon += __shfl_xor(bon, 32, 64);
  if (hh == 0) { red[tl * 2 + chh] = ssq; red[(32 + tl) * 2 + chh] = bon; }
  __syncthreads();
  const float ssq_t = red[tl * 2] + red[tl * 2 + 1];
  const float bon_t = red[(32 + tl) * 2] + red[(32 + tl) * 2 + 1];
  const float rn = rsqrtf(ssq_t + 1e-12f);
#pragma unroll
  for (int g4 = 0; g4 < 4; ++g4) {
    const int c0 = hq * 64 + chh * 32 + 8 * g4 + 4 * hh;
    size_t o = (size_t)m * 512 + c0;
    float kk[4];
#pragma unroll
    for (int j = 0; j < 4; ++j) kk[j] = kkf[4 * g4 + j] * rn;
    *reinterpret_cast<uint2*>(P.rnkk + o) = pack4(-kk[0], -kk[1], -kk[2], -kk[3]);
    *reinterpret_cast<uint2*>(P.rbk + o) =
        pack4(kk[0] * aF[4 * g4], kk[1] * aF[4 * g4 + 1], kk[2] * aF[4 * g4 + 2], kk[3] * aF[4 * g4 + 3]);
    *reinterpret_cast<uint2*>(P.rbk + (size_t)NTOK * 512 + o) =
        pack4(kk[0] * aB[4 * g4], kk[1] * aB[4 * g4 + 1], kk[2] * aB[4 * g4 + 2], kk[3] * aB[4 * g4 + 3]);
  }
  if (chh == 0 && hh == 0) P.rbon[(size_t)m * 8 + hq] = bon_t;
}

__device__ __forceinline__ void attn_item(const Params& P, int layer, int it) {
  int lane = ltid() & 63, wave = ltid() >> 6;
  int nkeys, qtok, head;
  const u16 *kb, *vt;
  if (it < 128) {
    int b = it >> 6, qb = it & 7; head = (it >> 3) & 7;
    int kvh = head >> 2;
    nkeys = 1280;
    qtok = NCTX + b * 1024 + qb * 128;
    size_t hb = ((size_t)(layer * 2 + b) * 2 + kvh);
    kb = P.klat + hb * 1280 * 64;
    vt = P.vtlat + hb * 64 * 1280;
  } else {
    int j = it - 128;
    int b = j >> 4, qb = j & 1; head = (j >> 1) & 7;
    int kvh = head >> 2;
    nkeys = 256;
    qtok = b * 256 + qb * 128;
    kb = P.kctx + (size_t)(b * 2 + kvh) * 256 * 64;
    vt = P.vtctx + (size_t)(b * 2 + kvh) * 64 * 256;
  }
  int q0 = qtok + wave * 32;
  int r31 = lane & 31, hh = lane >> 5;
  bf16x8 qf[4];
  {
    const u16* qp = P.qbuf + (size_t)(q0 + r31) * 512 + head * 64 + hh * 8;
#pragma unroll
    for (int ks = 0; ks < 4; ++ks) qf[ks] = ld8(qp + ks * 16);
  }
  f32x16 o[2];
  o[0] = zero16(); o[1] = zero16();
  float mrun = -1e30f, lrun = 0.f;
  for (int kt = 0; kt < nkeys; kt += 64) {
    f32x16 x[2];
#pragma unroll
    for (int sub = 0; sub < 2; ++sub) {
      x[sub] = zero16();
      const u16* kp = kb + (size_t)(kt + sub * 32 + r31) * 64 + hh * 8;
#pragma unroll
      for (int ks = 0; ks < 4; ++ks) x[sub] = mfma(ld8(kp + ks * 16), qf[ks], x[sub]);
    }
    float mx = -1e30f;
#pragma unroll
    for (int sub = 0; sub < 2; ++sub)
#pragma unroll
      for (int r = 0; r < 16; ++r) mx = fmaxf(mx, x[sub][r]);
    mx = fmaxf(mx, __shfl_xor(mx, 32, 64));
    float mnew = fmaxf(mrun, mx * 0.125f);
    float alpha = __expf(mrun - mnew);
    mrun = mnew;
    float psum = 0.f;
    bf16x8 pf[2][2];
#pragma unroll
    for (int sub = 0; sub < 2; ++sub)
#pragma unroll
      for (int r = 0; r < 16; ++r) {
        float pv = __expf(x[sub][r] * 0.125f - mnew);
        psum += pv;
        pf[sub][r >> 3][r & 7] = (short)f2bf(pv);
      }
    lrun = lrun * alpha + psum;
#pragma unroll
    for (int dt = 0; dt < 2; ++dt) {
#pragma unroll
      for (int r = 0; r < 16; ++r) o[dt][r] *= alpha;
      const u16* vp = vt + (size_t)(dt * 32 + r31) * nkeys + kt + 4 * hh;
#pragma unroll
      for (int sub = 0; sub < 2; ++sub)
#pragma unroll
        for (int s = 0; s < 2; ++s) {
          bf16x8 vf = ld4x2(vp + sub * 32 + 16 * s, vp + sub * 32 + 16 * s + 8);
          o[dt] = mfma(vf, pf[sub][s], o[dt]);
        }
    }
  }
  lrun += __shfl_xor(lrun, 32, 64);
  float inv = __builtin_amdgcn_rcpf(lrun);
  u16* op = P.ocat + (size_t)(q0 + r31) * 1536 + head * 64;
#pragma unroll
  for (int dt = 0; dt < 2; ++dt)
#pragma unroll
    for (int g = 0; g < 4; ++g) {
      int d = dt * 32 + 8 * g + 4 * hh;
      uint2 w;
      w.x = pack2(o[dt][4 * g + 0] * inv, o[dt][4 * g + 1] * inv);
      w.y = pack2(o[dt][4 * g + 2] * inv, o[dt][4 * g + 3] * inv);
      *reinterpret_cast<uint2*>(op + d) = w;
    }
}

__device__ __forceinline__ void gla_scan_item(const Params& P, int layer, int it) {
  int lane = ltid() & 63, wave = ltid() >> 6;
  int s, h, dir;
  if (it < 16) { s = 16 + (it >> 3); h = (it >> 1) & 3; dir = it & 1; }
  else { int j = it - 16; s = j >> 3; h = (j >> 1) & 3; dir = j & 1; }
  int sbase, T;
  seq_info(s, sbase, T);
  const int nch = T >> 6;
  const int r31 = lane & 31, hh = lane >> 5;
  const int dv = wave * 32 + r31;
  f32x16 S[2];
  if (s >= 16) {
    const float* sp = P.in[I_SG] + ((((size_t)(s - 16) * 4 + layer) * 2 + dir) * 4 + h) * 64 * 128;
#pragma unroll
    for (int d2 = 0; d2 < 2; ++d2)
#pragma unroll
      for (int r = 0; r < 16; ++r) S[d2][r] = sp[(size_t)(d2 * 32 + accrow(r, hh)) * 128 + dv];
  } else { S[0] = zero16(); S[1] = zero16(); }
  const u16* qeb = P.gqe + (size_t)dir * NTOK * 256 + h * 64;
  u16* obi = P.obi + (size_t)dir * NTOK * 512 + h * 128 + dv;
  bf16x8 qf[2][2][2];
  auto load_q = [&](int cs, bf16x8 (&q)[2][2][2]) {
    int ctok = dir ? nch - 1 - cs : cs;
    int m0 = sbase + ctok * 64;
#pragma unroll
    for (int tt = 0; tt < 2; ++tt) {
      int i = tt * 32 + r31;
      int tok = m0 + (dir ? 63 - i : i);
#pragma unroll
      for (int d2 = 0; d2 < 2; ++d2)
#pragma unroll
        for (int sx = 0; sx < 2; ++sx) {
          const u16* qp = qeb + (size_t)tok * 256 + d2 * 32 + 16 * sx + 4 * hh;
          q[tt][d2][sx] = ld4x2(qp, qp + 8);
        }
    }
  };
#pragma unroll 1
  for (int cs = 0; cs < nch; ++cs) {
    load_q(cs, qf);
    const int ctok = dir ? nch - 1 - cs : cs;
    const int m0 = sbase + ctok * 64;
    const int gchunk = m0 >> 6;
    const float* gu = P.gU + ((((size_t)dir * 96 + gchunk) * 4 + h) * 128 + dv) * 64 + 4 * hh;
    const float* dl = P.gdl + ((size_t)dir * 96 + gchunk) * 256 + h * 64 + 4 * hh;
    float4 U[2][4];
    float4 dlv[2][4];
#pragma unroll
    for (int d2 = 0; d2 < 2; ++d2)
#pragma unroll
      for (int g = 0; g < 4; ++g) {
        U[d2][g] = *reinterpret_cast<const float4*>(gu + d2 * 32 + 8 * g);
        dlv[d2][g] = *reinterpret_cast<const float4*>(dl + d2 * 32 + 8 * g);
      }
#pragma unroll
    for (int tt = 0; tt < 2; ++tt) {
      f32x16 O = zero16();
#pragma unroll
      for (int d2 = 0; d2 < 2; ++d2)
#pragma unroll
        for (int sx = 0; sx < 2; ++sx) O = mfma(qf[tt][d2][sx], acc2frag(S[d2], sx), O);
      {
        const int i0 = tt * 32 + 4 * hh;
        u16* po = obi + (size_t)(m0 + (dir ? 63 - i0 : i0)) * 512;
        const long step = dir ? -512 : 512;
#pragma unroll
        for (int g = 0; g < 4; ++g) {
          po[(8 * g + 0) * step] = f2bf(O[4 * g + 0]);
          po[(8 * g + 1) * step] = f2bf(O[4 * g + 1]);
          po[(8 * g + 2) * step] = f2bf(O[4 * g + 2]);
          po[(8 * g + 3) * step] = f2bf(O[4 * g + 3]);
          __builtin_amdgcn_sched_barrier(0);
        }
      }
    }
#pragma unroll
    for (int d2 = 0; d2 < 2; ++d2)
#pragma unroll
      for (int g = 0; g < 4; ++g) {
        S[d2][4 * g + 0] = S[d2][4 * g + 0] * dlv[d2][g].x + U[d2][g].x;
        S[d2][4 * g + 1] = S[d2][4 * g + 1] * dlv[d2][g].y + U[d2][g].y;
        S[d2][4 * g + 2] = S[d2][4 * g + 2] * dlv[d2][g].z + U[d2][g].z;
        S[d2][4 * g + 3] = S[d2][4 * g + 3] * dlv[d2][g].w + U[d2][g].w;
      }
  }
  if (s < 16) {
    float* sp = P.out + O_SG + ((((size_t)s * 4 + layer) * 2 + dir) * 4 + h) * 64 * 128;
#pragma unroll
    for (int d2 = 0; d2 < 2; ++d2)
#pragma unroll
      for (int r = 0; r < 16; ++r) sp[(size_t)(d2 * 32 + accrow(r, hh)) * 128 + dv] = S[d2][r];
  }
}

template <int CTRL, int RS>
__device__ __forceinline__ void dpp_stage(float (&x)[RS]) {
#pragma unroll
  for (int i = 0; i < RS; ++i) x[i] = dpp_addf<CTRL>(x[i]);
}
template <int RS>
__device__ __forceinline__ void rwkv_scan_item(const Params& P, int layer, int s, int h, int dir, int rb, char* smem) {
  constexpr int NR = 16 * RS;
  int tid = ltid(), lane = tid & 63, wave = tid >> 6;
  int sbase, T;
  seq_info(s, sbase, T);
  if (s >= 16) __builtin_amdgcn_s_setprio(3);
  const int lrow = wave * 4 + (lane >> 4);
  const int c0 = (lane & 15) * 4;
  float4 S[RS];
#pragma unroll
  for (int rs = 0; rs < RS; ++rs) {
    S[rs] = make_float4(0.f, 0.f, 0.f, 0.f);
    if (s >= 16)
      S[rs] = *reinterpret_cast<const float4*>(P.in[I_SR] + (((((size_t)(s - 16) * 4 + layer) * 2 + dir) * 8 + h) * 64 + rb * NR + rs * 16 + lrow) * 64 + c0);
  }
  constexpr int BUF = 5 * 1024 + 2 * 16 * NR;
  float* buf = (float*)smem;
  const int lst = tid >> 4, lc4 = (tid & 15) * 4;
  const u16* gR = P.rr + h * 64;
  const float* gW = P.rdec + (size_t)dir * NTOK * 512 + h * 64;
  const u16* gK = P.rkd + (size_t)dir * NTOK * 512 + h * 64;
  const u16* gA = P.rnkk + h * 64;
  const u16* gB = P.rbk + (size_t)dir * NTOK * 512 + h * 64;
  const u16* gV = P.rv + h * 64 + rb * NR;
  float* yo = P.ry + (size_t)dir * NTOK * 512 + h * 64 + rb * NR;
  float4 pr, pw, pk, pa, pb; float pv[RS];
  __syncthreads();
  {
    int tok = sbase + (dir ? T - 1 - lst : lst);
    size_t o = (size_t)tok * 512;
    pr = unpack4(*reinterpret_cast<const uint2*>(gR + o + lc4));
    pw = *reinterpret_cast<const float4*>(gW + o + lc4);
    pk = unpack4(*reinterpret_cast<const uint2*>(gK + o + lc4));
    pa = unpack4(*reinterpret_cast<const uint2*>(gA + o + lc4));
    pb = unpack4(*reinterpret_cast<const uint2*>(gB + o + lc4));
#pragma unroll
    for (int q = 0; q < RS; ++q) {
      int idx = tid + q * NTHREADS, st = idx / NR, rr = idx % NR;
      int tk = sbase + (dir ? T - 1 - st : st);
      pv[q] = bf2f(gV[(size_t)tk * 512 + rr]);
    }
    float* bw = buf;
    *reinterpret_cast<float4*>(bw + 0 * 1024 + lst * 64 + lc4) = pr;
    *reinterpret_cast<float4*>(bw + 1 * 1024 + lst * 64 + lc4) = pw;
    *reinterpret_cast<float4*>(bw + 2 * 1024 + lst * 64 + lc4) = pk;
    *reinterpret_cast<float4*>(bw + 3 * 1024 + lst * 64 + lc4) = pa;
    *reinterpret_cast<float4*>(bw + 4 * 1024 + lst * 64 + lc4) = pb;
#pragma unroll
    for (int q = 0; q < RS; ++q) bw[5 * 1024 + tid + q * NTHREADS] = pv[q];
  }
  __syncthreads();
  const int nch = T >> 4;
#pragma unroll 1
  for (int ch = 0; ch < nch; ++ch) {
    const int cur = ch & 1;
    if (ch + 1 < nch) {
      int si = (ch + 1) * 16 + lst;
      int tok = sbase + (dir ? T - 1 - si : si);
      size_t o = (size_t)tok * 512;
      pr = unpack4(*reinterpret_cast<const uint2*>(gR + o + lc4));
      pw = *reinterpret_cast<const float4*>(gW + o + lc4);
      pk = unpack4(*reinterpret_cast<const uint2*>(gK + o + lc4));
      pa = unpack4(*reinterpret_cast<const uint2*>(gA + o + lc4));
      pb = unpack4(*reinterpret_cast<const uint2*>(gB + o + lc4));
#pragma unroll
      for (int q = 0; q < RS; ++q) {
        int idx = tid + q * NTHREADS, st = idx / NR, rr = idx % NR;
        int s2 = (ch + 1) * 16 + st;
        int tk = sbase + (dir ? T - 1 - s2 : s2);
        pv[q] = bf2f(gV[(size_t)tk * 512 + rr]);
      }
    }
    float* bb = buf + cur * BUF;
    float4 r4 = *reinterpret_cast<const float4*>(bb + 0 * 1024 + c0);
    float4 w4 = *reinterpret_cast<const float4*>(bb + 1 * 1024 + c0);
    float4 k4 = *reinterpret_cast<const float4*>(bb + 2 * 1024 + c0);
    float4 a4 = *reinterpret_cast<const float4*>(bb + 3 * 1024 + c0);
    float4 b4 = *reinterpret_cast<const float4*>(bb + 4 * 1024 + c0);
    float vv[RS];
#pragma unroll
    for (int rs = 0; rs < RS; ++rs) vv[rs] = bb[5 * 1024 + rs * 16 + lrow];
#pragma unroll
    for (int st = 0; st < 16; ++st) {
      float4 nr4, nw4, nk4, na4, nb4; float nvv[RS];
      if (st + 1 < 16) {
        nr4 = *reinterpret_cast<const float4*>(bb + 0 * 1024 + (st + 1) * 64 + c0);
        nw4 = *reinterpret_cast<const float4*>(bb + 1 * 1024 + (st + 1) * 64 + c0);
        nk4 = *reinterpret_cast<const float4*>(bb + 2 * 1024 + (st + 1) * 64 + c0);
        na4 = *reinterpret_cast<const float4*>(bb + 3 * 1024 + (st + 1) * 64 + c0);
        nb4 = *reinterpret_cast<const float4*>(bb + 4 * 1024 + (st + 1) * 64 + c0);
#pragma unroll
        for (int rs = 0; rs < RS; ++rs) nvv[rs] = bb[5 * 1024 + (st + 1) * NR + rs * 16 + lrow];
      }
      float sa[RS], y[RS];
#pragma unroll
      for (int rs = 0; rs < RS; ++rs) sa[rs] = (S[rs].x * a4.x + S[rs].y * a4.y) + (S[rs].z * a4.z + S[rs].w * a4.w);
      dpp_stage<0xB1, RS>(sa); dpp_stage<0x4E, RS>(sa); dpp_stage<0x141, RS>(sa); dpp_stage<0x140, RS>(sa);
#pragma unroll
      for (int rs = 0; rs < RS; ++rs) {
        S[rs].x = S[rs].x * w4.x + (sa[rs] * b4.x + vv[rs] * k4.x);
        S[rs].y = S[rs].y * w4.y + (sa[rs] * b4.y + vv[rs] * k4.y);
        S[rs].z = S[rs].z * w4.z + (sa[rs] * b4.z + vv[rs] * k4.z);
        S[rs].w = S[rs].w * w4.w + (sa[rs] * b4.w + vv[rs] * k4.w);
        y[rs] = (S[rs].x * r4.x + S[rs].y * r4.y) + (S[rs].z * r4.z + S[rs].w * r4.w);
      }
      dpp_stage<0xB1, RS>(y); dpp_stage<0x4E, RS>(y); dpp_stage<0x141, RS>(y); dpp_stage<0x140, RS>(y);
      if ((lane & 15) == 0) {
#pragma unroll
        for (int rs = 0; rs < RS; ++rs) bb[5 * 1024 + 16 * NR + st * NR + rs * 16 + lrow] = y[rs];
      }
      if (st + 1 < 16) {
        r4 = nr4; w4 = nw4; k4 = nk4; a4 = na4; b4 = nb4;
#pragma unroll
        for (int rs = 0; rs < RS; ++rs) vv[rs] = nvv[rs];
      }
    }
    if (ch + 1 < nch) {
      float* bw = buf + (cur ^ 1) * BUF;
      *reinterpret_cast<float4*>(bw + 0 * 1024 + lst * 64 + lc4) = pr;
      *reinterpret_cast<float4*>(bw + 1 * 1024 + lst * 64 + lc4) = pw;
      *reinterpret_cast<float4*>(bw + 2 * 1024 + lst * 64 + lc4) = pk;
      *reinterpret_cast<float4*>(bw + 3 * 1024 + lst * 64 + lc4) = pa;
      *reinterpret_cast<float4*>(bw + 4 * 1024 + lst * 64 + lc4) = pb;
#pragma unroll
      for (int q = 0; q < RS; ++q) bw[5 * 1024 + tid + q * NTHREADS] = pv[q];
    }
    __syncthreads();
#pragma unroll
    for (int q = 0; q < RS; ++q) {
      int idx = tid + q * NTHREADS, st = idx / NR, rr = idx % NR;
      int si = ch * 16 + st;
      int tok = sbase + (dir ? T - 1 - si : si);
      yo[(size_t)tok * 512 + rr] = bb[5 * 1024 + 16 * NR + idx];
    }
  }
  if (s < 16) {
#pragma unroll
    for (int rs = 0; rs < RS; ++rs)
      *reinterpret_cast<float4*>(P.out + O_SR + (((((size_t)s * 4 + layer) * 2 + dir) * 8 + h) * 64 + rb * NR + rs * 16 + lrow) * 64 + c0) = S[rs];
  }
  if (s >= 16) __builtin_amdgcn_s_setprio(0);
}

typedef float f2_t __attribute__((ext_vector_type(2)));
__device__ __forceinline__ void rwkv_scan_lat(const Params& P, int layer, int it, char* smem) {
  const int tid = ltid(), lane = tid & 63, wave = tid >> 6;
  const int s = 16 + (it >> 6), h = (it >> 3) & 7, dir = (it >> 2) & 1, rb = it & 3;
  int sbase, T;
  seq_info(s, sbase, T);
  __builtin_amdgcn_s_setprio(3);
  const int lrow = wave * 4 + (lane >> 4);
  const int row = rb * 16 + lrow;
  const int l15 = lane & 15;
  const int c0 = l15 * 4;
  f2_t S01, S23;
  {
    float4 s4 = *reinterpret_cast<const float4*>(P.in[I_SR] + (((((size_t)(s - 16) * 4 + layer) * 2 + dir) * 8 + h) * 64 + row) * 64 + c0);
    S01 = (f2_t){s4.x, s4.y}; S23 = (f2_t){s4.z, s4.w};
  }
  constexpr int BUF = 5 * 1024 + 256;
  float* buf = (float*)smem;
  float* ypart = buf + 2 * BUF;
  const int lst = tid >> 4, lc4 = (tid & 15) * 4, lrr = tid & 15;
  const u16* gR = P.rr + h * 64;
  const float* gW = P.rdec + (size_t)dir * NTOK * 512 + h * 64;
  const u16* gK = P.rkd + (size_t)dir * NTOK * 512 + h * 64;
  const u16* gA = P.rnkk + h * 64;
  const u16* gB = P.rbk + (size_t)dir * NTOK * 512 + h * 64;
  const u16* gV = P.rv + h * 64 + rb * 16;
  float* yo = P.ry + (size_t)dir * NTOK * 512 + h * 64 + rb * 16;
  float4 pr, pw, pk, pa, pb; float pv;
  __syncthreads();
  {
    int tok = sbase + (dir ? T - 1 - lst : lst);
    size_t o = (size_t)tok * 512;
    pr = unpack4(*reinterpret_cast<const uint2*>(gR + o + lc4));
    pw = *reinterpret_cast<const float4*>(gW + o + lc4);
    pk = unpack4(*reinterpret_cast<const uint2*>(gK + o + lc4));
    pa = unpack4(*reinterpret_cast<const uint2*>(gA + o + lc4));
    pb = unpack4(*reinterpret_cast<const uint2*>(gB + o + lc4));
    pv = bf2f(gV[o + lrr]);
    float* bw = buf;
    *reinterpret_cast<float4*>(bw + 0 * 1024 + lst * 64 + lc4) = pr;
    *reinterpret_cast<float4*>(bw + 1 * 1024 + lst * 64 + lc4) = pw;
    *reinterpret_cast<float4*>(bw + 2 * 1024 + lst * 64 + lc4) = pk;
    *reinterpret_cast<float4*>(bw + 3 * 1024 + lst * 64 + lc4) = pa;
    *reinterpret_cast<float4*>(bw + 4 * 1024 + lst * 64 + lc4) = pb;
    bw[5 * 1024 + tid] = pv;
  }
  __syncthreads();
  const int nch = T >> 4;
#pragma unroll 1
  for (int ch = 0; ch < nch; ++ch) {
    const int cur = ch & 1;
    if (ch + 1 < nch) {
      int si = (ch + 1) * 16 + lst;
      int tok = sbase + (dir ? T - 1 - si : si);
      size_t o = (size_t)tok * 512;
      pr = unpack4(*reinterpret_cast<const uint2*>(gR + o + lc4));
      pw = *reinterpret_cast<const float4*>(gW + o + lc4);
      pk = unpack4(*reinterpret_cast<const uint2*>(gK + o + lc4));
      pa = unpack4(*reinterpret_cast<const uint2*>(gA + o + lc4));
      pb = unpack4(*reinterpret_cast<const uint2*>(gB + o + lc4));
      pv = bf2f(gV[o + lrr]);
    }
    const float* bb = buf + cur * BUF;
    float4 Rr[4], Rw[4], Rk[4], Ra[4], Rb[4]; float Rv[4];
#pragma unroll
    for (int q = 0; q < 3; ++q) {
      Rr[q] = *reinterpret_cast<const float4*>(bb + 0 * 1024 + q * 64 + c0);
      Rw[q] = *reinterpret_cast<const float4*>(bb + 1 * 1024 + q * 64 + c0);
      Rk[q] = *reinterpret_cast<const float4*>(bb + 2 * 1024 + q * 64 + c0);
      Ra[q] = *reinterpret_cast<const float4*>(bb + 3 * 1024 + q * 64 + c0);
      Rb[q] = *reinterpret_cast<const float4*>(bb + 4 * 1024 + q * 64 + c0);
      Rv[q] = bb[5 * 1024 + q * 16 + lrow];
    }
#pragma unroll
    for (int st = 0; st < 16; ++st) {
      if (st + 3 < 16) {
        const int q = (st + 3) & 3;
        Rr[q] = *reinterpret_cast<const float4*>(bb + 0 * 1024 + (st + 3) * 64 + c0);
        Rw[q] = *reinterpret_cast<const float4*>(bb + 1 * 1024 + (st + 3) * 64 + c0);
        Rk[q] = *reinterpret_cast<const float4*>(bb + 2 * 1024 + (st + 3) * 64 + c0);
        Ra[q] = *reinterpret_cast<const float4*>(bb + 3 * 1024 + (st + 3) * 64 + c0);
        Rb[q] = *reinterpret_cast<const float4*>(bb + 4 * 1024 + (st + 3) * 64 + c0);
        Rv[q] = bb[5 * 1024 + (st + 3) * 16 + lrow];
      }
      const float4 r4 = Rr[st & 3], w4 = Rw[st & 3], k4 = Rk[st & 3], a4 = Ra[st & 3], b4 = Rb[st & 3];
      const float vv = Rv[st & 3];
      const f2_t a01 = {a4.x, a4.y}, a23 = {a4.z, a4.w}, b01 = {b4.x, b4.y}, b23 = {b4.z, b4.w};
      const f2_t k01 = {k4.x, k4.y}, k23 = {k4.z, k4.w}, w01 = {w4.x, w4.y}, w23 = {w4.z, w4.w};
      const f2_t r01 = {r4.x, r4.y}, r23 = {r4.z, r4.w};
      f2_t t = S01 * a01;
      t = __builtin_elementwise_fma(S23, a23, t);
      float sa = t.x + t.y;
      sa = dpp_addf<0xB1>(sa); sa = dpp_addf<0x4E>(sa); sa = dpp_addf<0x141>(sa); sa = dpp_addf<0x140>(sa);
      const f2_t sa2 = {sa, sa}, vv2 = {vv, vv};
      f2_t u01 = sa2 * b01, u23 = sa2 * b23;
      u01 = __builtin_elementwise_fma(vv2, k01, u01);
      u23 = __builtin_elementwise_fma(vv2, k23, u23);
      S01 = __builtin_elementwise_fma(S01, w01, u01);
      S23 = __builtin_elementwise_fma(S23, w23, u23);
      f2_t y2 = S01 * r01;
      y2 = __builtin_elementwise_fma(S23, r23, y2);
      ypart[(st * 16 + lrow) * 16 + l15] = y2.x + y2.y;
    }
    if (ch + 1 < nch) {
      float* bw = buf + (cur ^ 1) * BUF;
      *reinterpret_cast<float4*>(bw + 0 * 1024 + lst * 64 + lc4) = pr;
      *reinterpret_cast<float4*>(bw + 1 * 1024 + lst * 64 + lc4) = pw;
      *reinterpret_cast<float4*>(bw + 2 * 1024 + lst * 64 + lc4) = pk;
      *reinterpret_cast<float4*>(bw + 3 * 1024 + lst * 64 + lc4) = pa;
      *reinterpret_cast<float4*>(bw + 4 * 1024 + lst * 64 + lc4) = pb;
      bw[5 * 1024 + tid] = pv;
    }
    __syncthreads();
    {
      const float4* yp = reinterpret_cast<const float4*>(ypart + tid * 16);
      float4 q0 = yp[0], q1 = yp[1], q2 = yp[2], q3 = yp[3];
      float ys = ((q0.x + q0.y) + (q0.z + q0.w)) + ((q1.x + q1.y) + (q1.z + q1.w)) +
                 (((q2.x + q2.y) + (q2.z + q2.w)) + ((q3.x + q3.y) + (q3.z + q3.w)));
      int si = ch * 16 + lst;
      int tok = sbase + (dir ? T - 1 - si : si);
      yo[(size_t)tok * 512 + lrr] = ys;
    }
    __syncthreads();
  }
  __builtin_amdgcn_s_setprio(0);
}

__device__ __forceinline__ void post_item(const Params& P, int layer, int it) {
  int lane = ltid() & 63, wave = ltid() >> 6;
  int m = it * 4 + wave;
  {
    float va[8], vb[8], vc8[8], vd[8], v[8];
    unpack8(*reinterpret_cast<const uint4*>(P.ob + (size_t)m * 512 + lane * 8), va);
    unpack8(*reinterpret_cast<const uint4*>(P.ob + (size_t)(NTOK + m) * 512 + lane * 8), vb);
    unpack8(*reinterpret_cast<const uint4*>(P.obi + (size_t)m * 512 + lane * 8), vc8);
    unpack8(*reinterpret_cast<const uint4*>(P.obi + (size_t)(NTOK + m) * 512 + lane * 8), vd);
#pragma unroll
    for (int i = 0; i < 8; ++i) v[i] = (va[i] + vc8[i]) + (vb[i] + vd[i]);
    float ss = 0.f;
#pragma unroll
    for (int i = 0; i < 8; ++i) ss += v[i] * v[i];
    ss = group_sum<16>(ss);
    float rs = rsqrtf(ss * (1.f / 128.f) + 1e-6f);
    float gb[8];
    unpack8(*reinterpret_cast<const uint4*>(P.p + (size_t)m * LDP + OFF_GB + lane * 8), gb);
#pragma unroll
    for (int i = 0; i < 8; ++i) v[i] = v[i] * rs * P.in[I_GLAG][layer * 128 + (lane & 15) * 8 + i] * siluf_(gb[i]);
    *reinterpret_cast<uint4*>(P.ocat + (size_t)m * 1536 + 512 + lane * 8) = pack8(v);
  }
  {
    const float* a = P.ry + (size_t)m * 512 + lane * 8;
    const float* b = a + (size_t)NTOK * 512;
    float v[8];
    float4 a0 = *reinterpret_cast<const float4*>(a), a1 = *reinterpret_cast<const float4*>(a + 4);
    float4 b0 = *reinterpret_cast<const float4*>(b), b1 = *reinterpret_cast<const float4*>(b + 4);
    v[0] = a0.x + b0.x; v[1] = a0.y + b0.y; v[2] = a0.z + b0.z; v[3] = a0.w + b0.w;
    v[4] = a1.x + b1.x; v[5] = a1.y + b1.y; v[6] = a1.z + b1.z; v[7] = a1.w + b1.w;
    float sm = 0.f;
#pragma unroll
    for (int i = 0; i < 8; ++i) sm += v[i];
    sm = group_sum<8>(sm);
    float mean = sm * (1.f / 64.f);
    float vs = 0.f;
#pragma unroll
    for (int i = 0; i < 8; ++i) { float dd = v[i] - mean; vs += dd * dd; }
    vs = group_sum<8>(vs);
    float rs = rsqrtf(vs * (1.f / 64.f) + 64e-5f);
    float bon = P.rbon[(size_t)m * 8 + (lane >> 3)];
    int c = lane * 8;
    float vc[8], gc[8];
    unpack8(*reinterpret_cast<const uint4*>(P.rv + (size_t)m * 512 + c), vc);
    unpack8(*reinterpret_cast<const uint4*>(P.rgc + (size_t)m * 512 + c), gc);
#pragma unroll
    for (int i = 0; i < 8; ++i) {
      float gn = (v[i] - mean) * rs * P.in[I_LNW][layer * 512 + c + i] + P.in[I_LNB][layer * 512 + c + i];
      v[i] = (gn + bon * vc[i]) * gc[i];
    }
    *reinterpret_cast<uint4*>(P.ocat + (size_t)m * 1536 + 1024 + c) = pack8(v);
  }
}

#define XB_TMO      128
#define XB_XCNT(j)  (256  + 64 * (j))
#define XB_XSUB(j)  (1280 + 64 * (j))
#define XB_XGEN(j)  (2304 + 64 * (j))
#define XB_TOP      3328
#define XB_TOPGEN   3392
#define XCD_BAR_WORDS 3456
#define XB_SPIN_CAP (1u << 22)
__device__ __forceinline__ unsigned xb_ld(unsigned* p) { return __hip_atomic_load(p, __ATOMIC_RELAXED, __HIP_MEMORY_SCOPE_AGENT); }
__device__ __forceinline__ unsigned xb_add(unsigned* p, unsigned v) { return __hip_atomic_fetch_add(p, v, __ATOMIC_RELAXED, __HIP_MEMORY_SCOPE_AGENT); }
__device__ __forceinline__ unsigned xb_xcc_id() { return (unsigned)__builtin_amdgcn_s_getreg((3 << 11) | 20) & 0xFu; }
#define XB_SPIN(cond, bar) do { unsigned _sp = 0; while (cond) { __builtin_amdgcn_s_sleep(1); \
    if ((++_sp & 255u) == 0u) { if (xb_ld(&(bar)[XB_TMO])) break; if (_sp > XB_SPIN_CAP) { atomicAdd(&(bar)[XB_TMO], 1u); break; } } } } while (0)
struct XcdBarrier { unsigned* bar; unsigned x; unsigned nloc; unsigned nx; };
__device__ __forceinline__ XcdBarrier xcd_barrier_post(unsigned* bar) {
  XcdBarrier b; b.bar = bar; b.x = xb_xcc_id(); b.nloc = 0u; b.nx = 0u;
  if (threadIdx.x == 0) (void)xb_add(&bar[XB_XCNT(b.x)], 1u);
  return b;
}
__device__ __forceinline__ void xcd_barrier_complete(unsigned* bar, unsigned x, unsigned& nloc, unsigned& nx) {
  const unsigned G = gridDim.x;
  unsigned sum, cnt, mine, sp = 0u;
  for (;;) {
    sum = 0u; cnt = 0u; mine = 0u;
#pragma unroll
    for (unsigned j = 0; j < 16; ++j) { const unsigned c = xb_ld(&bar[XB_XCNT(j)]); sum += c; cnt += (c > 0u) ? 1u : 0u; mine = (j == x) ? c : mine; }
    if (sum == G) break;
    __builtin_amdgcn_s_sleep(1);
    if ((++sp & 255u) == 0u) { if (xb_ld(&bar[XB_TMO])) break; if (sp > XB_SPIN_CAP) { atomicAdd(&bar[XB_TMO], 1u); break; } }
  }
  nloc = mine > 0u ? mine : 1u; nx = cnt > 0u ? cnt : 1u;
}
__device__ __forceinline__ void xcd_barrier(XcdBarrier& b) {
  asm volatile("s_waitcnt vmcnt(0)" ::: "memory");
  __syncthreads();
  if (threadIdx.x == 0) {
    unsigned* bar = b.bar;
    __builtin_amdgcn_s_waitcnt(0);
    if (b.nloc == 0u) xcd_barrier_complete(bar, b.x, b.nloc, b.nx);
    const unsigned nloc = b.nloc, nx = b.nx;
    const unsigned old = xb_add(&bar[XB_XSUB(b.x)], 1u);
    const unsigned gen = old / nloc;
    if (old + 1u == (gen + 1u) * nloc) {
      __builtin_amdgcn_fence(__ATOMIC_RELEASE, "agent");
      asm volatile("s_waitcnt vmcnt(0)" ::: "memory");
      const unsigned og = xb_add(&bar[XB_TOP], 1u);
      const unsigned tg = og / nx;
      if (og + 1u == (tg + 1u) * nx) xb_add(&bar[XB_TOPGEN], 1u);
      else XB_SPIN(xb_ld(&bar[XB_TOPGEN]) == tg, bar);
      __builtin_amdgcn_fence(__ATOMIC_ACQUIRE, "agent");
      xb_add(&bar[XB_XGEN(b.x)], 1u);
      asm volatile("s_waitcnt vmcnt(0)" ::: "memory");
    } else {
      XB_SPIN(xb_ld(&bar[XB_XGEN(b.x)]) == gen, bar);
      __builtin_amdgcn_fence(__ATOMIC_ACQUIRE, "agent");
      asm volatile("s_waitcnt vmcnt(0)" ::: "memory");
    }
  }
  __syncthreads();
}

constexpr int N_PHASES = 1 + 10 * DEPTH;

__device__ __forceinline__ void run_phase(const Params& P, int layer, int sub, char* smem, int rep = 0) {
  const int G = gridDim.x, b = lbid();
  if (sub < 0) {
    const int total = 384 + CV_TOTAL + 1024;
    for (int it = b; it < total; it += G) {
      if (it < 384) adaln_item(P, it, smem);
      else if (it < 384 + CV_TOTAL) convert_item(P, 0, it - 384, smem);
      else cache_item(P, it - 384 - CV_TOTAL);
    }
    return;
  }
  switch (sub) {
    case 0: for (int it = b; it < NTOK / 4; it += G) norm_item(P, layer, 0, it); break;
    case 1: gemm_in_phase(P, layer, smem); break;
    case 2: {
      const int n1 = 768, n2 = 384, n3 = NTOK / 16;
      unsigned* ctr = P.bar + XCD_BAR_WORDS + rep * 512 + 256 + layer * 64;
      volatile int* sitem = (volatile int*)(smem + 65528);
      int npop = 0;
      for (;;) {
        __syncthreads();
        if (threadIdx.x == 0) *sitem = (npop < 2) ? npop * G + b : (int)(2 * G + atomicAdd(ctr, 1u));
        __syncthreads();
        ++npop;
        const int it = *sitem;
        if (it >= n1 + n2 + n3) break;
        if (it < n2) gla_prep_item(P, layer, it, smem);
        else if (it < n1 + n2) rwkv_prep_item(P, layer, it - n2, smem);
        else { for (int q = 0; q < 4; ++q) attn_prep_item(P, layer, (it - n1 - n2) * 4 + q); }
      }
    } break;
    case 3: {
      const int ncv = (layer + 1 < DEPTH) ? (CV_TOTAL + 1) / 2 : 0;
      const int total = 912 + ncv;
      unsigned* ctr = P.bar + XCD_BAR_WORDS + rep * 512 + layer * 64;
      volatile int* sitem = (volatile int*)(smem + 65528);
      bool first = true;
      for (;;) {
        __syncthreads();
        if (threadIdx.x == 0) *sitem = first ? b : (int)(G + atomicAdd(ctr, 1u));
        __syncthreads();
        first = false;
        const int it = *sitem;
        if (it >= total) break;
        if (it < 128) rwkv_scan_lat(P, layer, it, smem);
        else if (it < 144) { for (int q = 0; q < 1 + (PROBE_D == 2); ++q) gla_scan_item(P, layer, it - 128); }
        else if (it < 272) { for (int q = 0; q < 1 + (PROBE_D == 3); ++q) attn_item(P, layer, it - 144); }
        else if (it < 528) { int j = it - 272; rwkv_scan_item<4>(P, layer, j >> 4, (j >> 1) & 7, j & 1, 0, smem); }
        else if (it < 656) gla_scan_item(P, layer, it - 528 + 16);
        else if (it < 912) attn_item(P, layer, it - 656 + 128);
        else {
          const int c0 = (it - 912) * 2;
          for (int q = 0; q < 2; ++q)
            if (c0 + q < CV_TOTAL) convert_item(P, layer + 1, c0 + q, smem);
        }
      }
    } break;
    case 4: for (int it = b; it < NTOK / 4; it += G) post_item(P, layer, it); break;
    case 5: gemm_po_phase(P, layer, smem); break;
    case 6: gemm_res_phase(P, layer, 0, smem); break;
    case 7: for (int it = b; it < NTOK / 4; it += G) norm_item(P, layer, 1, it); break;
    case 8: gemm_ffi_phase(P, layer, smem); break;
    case 9: gemm_res_phase(P, layer, 1, smem); break;
  }
}

#if !MEGA
template <int SUB>
__global__ void __launch_bounds__(NTHREADS, 2) phase_kernel(Params P, int layer) {
  __shared__ __attribute__((aligned(16))) char smem[65536];
  run_phase(P, layer, SUB, smem);
}
#else
__global__ void __launch_bounds__(NTHREADS, 2) mega_kernel(Params P) {
  __shared__ __attribute__((aligned(16))) char smem[65536];
  cg::grid_group grid = cg::this_grid();
  if (P.out == nullptr) grid.sync();
  XcdBarrier xb = xcd_barrier_post(P.bar);
  for (int ph = 0; ph < N_PHASES; ++ph) {
    int layer = (ph == 0) ? 0 : (ph - 1) / 10;
    int sub = (ph == 0) ? -1 : (ph - 1) % 10;
    run_phase(P, layer, sub, smem);
    if (PROBE_DUP && sub >= 0 && ((PROBE_DUP >> sub) & 1)) { xcd_barrier(xb); run_phase(P, layer, sub, smem, 1); }
    if (ph + 1 < N_PHASES) { for (int q = 0; q < PROBE_SYNCN; ++q) xcd_barrier(xb); }
  }
}
#endif

extern "C" void kernel_launch(void* const* d_in, const int* in_sizes, int n_in, void* d_out, int out_size, void* d_ws,
                              size_t ws_size, hipStream_t stream) {
  Params P{};
  for (int i = 0; i < N_INPUTS; ++i) P.in[i] = (const float*)d_in[i];
  P.out = (float*)d_out;
  char* w = (char*)d_ws;
  size_t off = 0;
  auto alloc = [&](size_t bytes) { char* r = w + off; off += (bytes + 255) & ~(size_t)255; return r; };
  P.wb[0] = (u16*)alloc(WB_TOTAL * 2);
  P.wb[1] = (u16*)alloc(WB_TOTAL * 2);
  P.mod = (float*)alloc((size_t)4 * 3 * 6144 * 4);
  P.h = (u16*)alloc((size_t)NTOK * D * 2);
  P.p = (u16*)alloc((size_t)NTOK * LDP * 2);
  P.qbuf = (u16*)alloc((size_t)NTOK * 512 * 2);
  P.kctx = (u16*)alloc((size_t)16 * 2 * 256 * 64 * 2);
  P.vtctx = (u16*)alloc((size_t)16 * 2 * 64 * 256 * 2);
  P.klat = (u16*)alloc((size_t)4 * 2 * 2 * 1280 * 64 * 2);
  P.vtlat = (u16*)alloc((size_t)4 * 2 * 2 * 64 * 1280 * 2);
  P.gqe = (u16*)alloc((size_t)2 * NTOK * 256 * 2);
  P.gke = (u16*)alloc((size_t)2 * NTOK * 256 * 2);
  P.gklT = (u16*)alloc((size_t)2 * 96 * 4 * 64 * 64 * 2);
  P.gvT = (u16*)alloc((size_t)2 * 96 * 4 * 128 * 64 * 2);
  P.gdl = (float*)alloc((size_t)2 * 96 * 256 * 4);
  P.ob = (u16*)alloc((size_t)2 * NTOK * 512 * 2);
  P.obi = (u16*)alloc((size_t)2 * NTOK * 512 * 2);
  P.gU = (float*)alloc((size_t)2 * 96 * 4 * 64 * 128 * 4);
  P.rr = (u16*)alloc((size_t)NTOK * 512 * 2);
  P.rv = (u16*)alloc((size_t)NTOK * 512 * 2);
  P.rnkk = (u16*)alloc((size_t)NTOK * 512 * 2);
  P.rdec = (float*)alloc((size_t)2 * NTOK * 512 * 4);
  P.rkd = (u16*)alloc((size_t)2 * NTOK * 512 * 2);
  P.rbk = (u16*)alloc((size_t)2 * NTOK * 512 * 2);
  P.rgc = (u16*)alloc((size_t)NTOK * 512 * 2);
  P.rbon = (float*)alloc((size_t)NTOK * 8 * 4);
  P.ry = (float*)alloc((size_t)2 * NTOK * 512 * 4);
  P.ocat = (u16*)alloc((size_t)NTOK * 1536 * 2);
  P.bar = (unsigned*)alloc((size_t)(XCD_BAR_WORDS + 1024) * 4);
  if (off > ws_size) { fprintf(stderr, "workspace too small: need %zu have %zu\n", off, ws_size); return; }

  static int grid_blocks = 0;
  if (!grid_blocks) {
    int dev = 0, cus = 0, per_cu = 0;
    hipGetDevice(&dev);
    hipDeviceGetAttribute(&cus, hipDeviceAttributeMultiprocessorCount, dev);
#if MEGA
    hipOccupancyMaxActiveBlocksPerMultiprocessor(&per_cu, mega_kernel, NTHREADS, 0);
#else
    hipOccupancyMaxActiveBlocksPerMultiprocessor(&per_cu, phase_kernel<1>, NTHREADS, 0);
#endif
    if (per_cu < 1) per_cu = 1;
    if (per_cu > 2) per_cu = 2;
    grid_blocks = cus * per_cu;
  }
#if MEGA
  hipMemsetAsync(P.bar, 0, (size_t)(XCD_BAR_WORDS + 1024) * 4, stream);
  void* args[] = {&P};
  hipError_t e = hipLaunchCooperativeKernel((void*)mega_kernel, dim3(grid_blocks), dim3(NTHREADS), args, 0, stream);
  if (e != hipSuccess) fprintf(stderr, "cooperative launch failed: %s (grid %d)\n", hipGetErrorString(e), grid_blocks);
#else
  phase_kernel<-1><<<grid_blocks, NTHREADS, 0, stream>>>(P, 0);
  for (int l = 0; l < DEPTH; ++l) {
    for (int q = 0; q < 1 + ((PROBE_DUP >> 0) & 1); ++q) phase_kernel<0><<<grid_blocks, NTHREADS, 0, stream>>>(P, l);
    for (int q = 0; q < 1 + ((PROBE_DUP >> 1) & 1); ++q) phase_kernel<1><<<grid_blocks, NTHREADS, 0, stream>>>(P, l);
    for (int q = 0; q < 1 + ((PROBE_DUP >> 2) & 1); ++q) phase_kernel<2><<<grid_blocks, NTHREADS, 0, stream>>>(P, l);
    for (int q = 0; q < 1 + ((PROBE_DUP >> 3) & 1); ++q) phase_kernel<3><<<grid_blocks, NTHREADS, 0, stream>>>(P, l);
    for (int q = 0; q < 1 + ((PROBE_DUP >> 4) & 1); ++q) phase_kernel<4><<<grid_blocks, NTHREADS, 0, stream>>>(P, l);
    for (int q = 0; q < 1 + ((PROBE_DUP >> 5) & 1); ++q) phase_kernel<5><<<grid_blocks, NTHREADS, 0, stream>>>(P, l);
    for (int q = 0; q < 1 + ((PROBE_DUP >> 6) & 1); ++q) phase_kernel<6><<<grid_blocks, NTHREADS, 0, stream>>>(P, l);
    for (int q = 0; q < 1 + ((PROBE_DUP >> 7) & 1); ++q) phase_kernel<7><<<grid_blocks, NTHREADS, 0, stream>>>(P, l);
    for (int q = 0; q < 1 + ((PROBE_DUP >> 8) & 1); ++q) phase_kernel<8><<<grid_blocks, NTHREADS, 0, stream>>>(P, l);
    for (int q = 0; q < 1 + ((PROBE_DUP >> 9) & 1); ++q) phase_kernel<9><<<grid_blocks, NTHREADS, 0, stream>>>(P, l);
  }
#endif
}
```
